# Optimizing an MI355X kernel written in HIP

```python
import math
import jax, jax.numpy as jnp
from jax import lax
import numpy as np

D_MODEL = 1024
BATCH = 2
SEQ = 8192
DEPTH = 4

N_MIXERS = 3
N_CONV_LAYERS = (DEPTH + 2) // 3
N_DIL_LAYERS = (DEPTH + 1) // 3
N_RWKV_LAYERS = DEPTH // 3

CONV_WIDTH = 31
DIL_GROUPS = ((128, 1), (512, 4), (2048, 16))
DIL_HEADS = 16
DIL_HEAD_DIM = D_MODEL // DIL_HEADS
REL_BUCKETS = 32
REL_MAX_DIST = 2048
RWKV_HEAD = 64
RWKV_HEADS = D_MODEL // RWKV_HEAD
DECAY_LORA = 64
ICLR_LORA = 64
GATE_LORA = 128
RWKV_GN_EPS = 64e-5
MEM_LEN = 256
XATTN_HEADS = 4
XATTN_HEAD_DIM = D_MODEL // XATTN_HEADS
D_FF = 4 * D_MODEL
DEEPNORM_ALPHA = (2 * DEPTH) ** 0.25
DEEPNORM_BETA = (8 * DEPTH) ** -0.25
LN_EPS = 1e-5

kernel_name = "hybrid_conv_dilattn_rwkv7_deepnorm"

F32 = jnp.float32


def layer_norm(x, g, b, eps=LN_EPS):
    xf = x.astype(F32)
    mu = jnp.mean(xf, axis=-1, keepdims=True)
    var = jnp.mean(jnp.square(xf - mu), axis=-1, keepdims=True)
    return ((xf - mu) * lax.rsqrt(var + eps) * g + b).astype(x.dtype)


def conv_module(x, w_in, b_in, dw, dw_b, ln_g, ln_b, w_out, b_out):
    h = x @ w_in + b_in
    val, gate = jnp.split(h, 2, axis=-1)
    h = val * jax.nn.sigmoid(gate)
    h = lax.conv_general_dilated(
        h, dw[:, None, :].astype(h.dtype), window_strides=(1,),
        padding=[(CONV_WIDTH - 1, 0)],
        dimension_numbers=('NWC', 'WIO', 'NWC'),
        feature_group_count=D_MODEL) + dw_b
    h = jax.nn.silu(layer_norm(h, ln_g, ln_b))
    return h @ w_out + b_out


def t5_causal_bucket(dist):
    n = jnp.maximum(dist, 0)
    max_exact = REL_BUCKETS // 2
    nf = jnp.maximum(n, 1).astype(F32)
    large = max_exact + (jnp.log(nf / max_exact) / math.log(REL_MAX_DIST / max_exact)
                         * (REL_BUCKETS - max_exact)).astype(jnp.int32)
    large = jnp.minimum(large, REL_BUCKETS - 1)
    return jnp.where(n < max_exact, n, large)


def dilated_group_attention(q, k, v, window, dilation, rel_bias):
    b, s, h, e = q.shape
    blk = window // dilation
    sub_len = s // dilation
    nb = -(-sub_len // blk)
    lp = nb * blk

    def to_blocks(t):
        t = t.reshape(b, sub_len, dilation, h, e).transpose(0, 2, 1, 3, 4)
        t = jnp.pad(t, ((0, 0), (0, 0), (0, lp - sub_len), (0, 0), (0, 0)))
        return t.reshape(b, dilation, nb, blk, h, e)

    def with_prev(t):
        prev = jnp.pad(t[:, :, :-1], ((0, 0), (0, 0), (1, 0), (0, 0), (0, 0), (0, 0)))
        return jnp.concatenate([prev, t], axis=3)

    qb = to_blocks(q)
    kw = with_prev(to_blocks(k))
    vw = with_prev(to_blocks(v))
    logits = jnp.einsum('bdnqhe,bdnkhe->bdnhqk', qb, kw,
                        preferred_element_type=F32) * (e ** -0.5)
    qi = jnp.arange(blk)[:, None]
    kj = jnp.arange(2 * blk)[None, :]
    rel = qi + blk - kj
    key_pos = jnp.arange(nb)[:, None, None] * blk + kj[None] - blk
    valid = ((rel >= 0) & (rel <= blk))[None] & (key_pos >= 0)
    bias = jnp.transpose(rel_bias[t5_causal_bucket(rel * dilation)], (2, 0, 1)).astype(F32)
    logits = jnp.where(valid[None, None, :, None], logits + bias[None, None, None], -jnp.inf)
    m = jnp.max(logits, axis=-1, keepdims=True)
    p = jnp.exp(logits - m)
    den = jnp.sum(p, axis=-1, keepdims=True)
    o = jnp.einsum('bdnhqk,bdnkhe->bdnqhe', p / den, vw.astype(F32))
    lse = (m + jnp.log(den))[..., 0]
    o = o.reshape(b, dilation, lp, h, e)[:, :, :sub_len].transpose(0, 2, 1, 3, 4).reshape(b, s, h, e)
    lse = jnp.swapaxes(lse, -1, -2).reshape(b, dilation, lp, h)[:, :, :sub_len]
    lse = lse.transpose(0, 2, 1, 3).reshape(b, s, h)
    return o, lse


def dilated_attention(x, w_qkv, w_out, rel_bias):
    b, s, _ = x.shape
    n_groups = len(DIL_GROUPS)
    qkv = (x @ w_qkv).reshape(b, s, n_groups, 3, DIL_HEADS, DIL_HEAD_DIM)
    outs, lses = [], []
    for g, (win, dil) in enumerate(DIL_GROUPS):
        o, lse = dilated_group_attention(qkv[:, :, g, 0], qkv[:, :, g, 1], qkv[:, :, g, 2],
                                         win, dil, rel_bias)
        outs.append(o)
        lses.append(lse)
    wts = jax.nn.softmax(jnp.stack(lses), axis=0)
    o = jnp.einsum('gbsh,gbshe->bshe', wts, jnp.stack(outs))
    return o.reshape(b, s, DIL_HEADS * DIL_HEAD_DIM).astype(x.dtype) @ w_out


def rwkv7_time_mix(x, mu, w_rkv, w0, w1, w2, a0, a1, a2, g1, g2, k_k, k_a, r_k,
                   lnx_g, lnx_b, w_out):
    b, t, c = x.shape
    h, n = RWKV_HEADS, RWKV_HEAD
    xx = jnp.pad(x, ((0, 0), (1, 0), (0, 0)))[:, :-1] - x
    xs = x[None] + xx[None] * mu[:, None, None, :]
    rkv = jnp.einsum('sbtc,scd->sbtd', xs[:3], w_rkv)
    r, k, v = rkv[0], rkv[1], rkv[2]
    xw, xa, xg = xs[3], xs[4], xs[5]
    w_log = -jax.nn.softplus(-(w0 + jnp.tanh(xw @ w1) @ w2)) - 0.5
    decay = jnp.exp(-jnp.exp(w_log.astype(F32)))
    a = jax.nn.sigmoid(a0 + (xa @ a1) @ a2)
    g = jax.nn.sigmoid(xg @ g1) @ g2

    def heads(z):
        return z.astype(F32).reshape(b, t, h, n)

    kk = heads(k * k_k)
    kk = kk / jnp.maximum(jnp.sqrt(jnp.sum(jnp.square(kk), axis=-1, keepdims=True)), 1e-12)
    k = k * (1 + (a - 1) * k_a)
    r_h, k_h, v_h, a_h = heads(r), heads(k), heads(v), heads(a)
    w_h = decay.reshape(b, t, h, n)

    def step(state, inp):
        r_t, w_t, k_t, v_t, kk_t, a_t = inp
        sa = jnp.einsum('bhvk,bhk->bhv', state, -kk_t)
        state = (state * w_t[:, :, None, :]
                 + sa[..., None] * (kk_t * a_t)[:, :, None, :]
                 + v_t[..., None] * k_t[:, :, None, :])
        return state, jnp.einsum('bhvk,bhk->bhv', state, r_t)

    def seq_first(z):
        return jnp.swapaxes(z, 0, 1)

    state0 = jnp.zeros((b, h, n, n), F32)
    _, y = lax.scan(step, state0, (seq_first(r_h), seq_first(w_h), seq_first(k_h),
                                   seq_first(v_h), seq_first(kk), seq_first(a_h)))
    y = jnp.swapaxes(y, 0, 1)
    y_mu = jnp.mean(y, axis=-1, keepdims=True)
    y_var = jnp.mean(jnp.square(y - y_mu), axis=-1, keepdims=True)
    y = ((y - y_mu) * lax.rsqrt(y_var + RWKV_GN_EPS)).reshape(b, t, c) * lnx_g + lnx_b
    bonus = jnp.sum(r_h * k_h * r_k.astype(F32), axis=-1, keepdims=True) * v_h
    y = y + bonus.reshape(b, t, c)
    return (y * g).astype(x.dtype) @ w_out


def memory_cross_attention(x, mem, w_q, w_kv, w_out):
    b, s, _ = x.shape
    q = (x @ w_q).reshape(b, s, XATTN_HEADS, XATTN_HEAD_DIM)
    kv = (mem @ w_kv).reshape(b, mem.shape[1], 2, XATTN_HEADS, XATTN_HEAD_DIM)
    logits = jnp.einsum('bshe,bmhe->bhsm', q, kv[:, :, 0],
                        preferred_element_type=F32) * (XATTN_HEAD_DIM ** -0.5)
    p = jax.nn.softmax(logits, axis=-1)
    o = jnp.einsum('bhsm,bmhe->bshe', p, kv[:, :, 1].astype(F32))
    return o.reshape(b, s, D_MODEL).astype(x.dtype) @ w_out


def sq_relu_mlp(x, w1, w2):
    return jnp.square(jax.nn.relu(x @ w1)) @ w2


def setup_inputs(seed: int = 0) -> dict:
    key = jax.random.key(seed)
    ks = iter(jax.random.split(key, 40))

    def normal(shape, scale):
        return jax.random.normal(next(ks), shape, F32) * scale

    D = D_MODEL
    nA, nB, nC = N_CONV_LAYERS, N_DIL_LAYERS, N_RWKV_LAYERS
    qkv_cols = len(DIL_GROUPS) * 3 * DIL_HEADS * DIL_HEAD_DIM
    inp = {}
    inp["x"] = normal((BATCH, SEQ, D), 1.0)
    inp["mem"] = normal((BATCH, MEM_LEN, D), 1.0)
    inp["rel_bias"] = normal((REL_BUCKETS, DIL_HEADS), 0.5)
    inp["a_w_in"] = normal((nA, D, 2 * D), D ** -0.5)
    inp["a_b_in"] = normal((nA, 2 * D), 0.02)
    inp["a_dw"] = normal((nA, CONV_WIDTH, D), CONV_WIDTH ** -0.5)
    inp["a_dw_b"] = normal((nA, D), 0.02)
    inp["a_ln_g"] = 1.0 + normal((nA, D), 0.02)
    inp["a_ln_b"] = normal((nA, D), 0.02)
    inp["a_w_out"] = normal((nA, D, D), D ** -0.5 * DEEPNORM_BETA)
    inp["a_b_out"] = normal((nA, D), 0.02)
    inp["b_w_qkv"] = normal((nB, D, qkv_cols), D ** -0.5)
    inp["b_w_out"] = normal((nB, DIL_HEADS * DIL_HEAD_DIM, D),
                            (DIL_HEADS * DIL_HEAD_DIM) ** -0.5 * DEEPNORM_BETA)
    inp["c_mu"] = jax.random.uniform(next(ks), (nC, 6, D), F32)
    inp["c_w_rkv"] = normal((nC, 3, D, D), D ** -0.5)
    inp["c_w0"] = jnp.linspace(-6.5, -1.5, D, dtype=F32)[None] + normal((nC, D), 0.1)
    inp["c_w1"] = normal((nC, D, DECAY_LORA), D ** -0.5)
    inp["c_w2"] = normal((nC, DECAY_LORA, D), DECAY_LORA ** -0.5 * 0.1)
    inp["c_a0"] = normal((nC, D), 0.1)
    inp["c_a1"] = normal((nC, D, ICLR_LORA), D ** -0.5)
    inp["c_a2"] = normal((nC, ICLR_LORA, D), ICLR_LORA ** -0.5 * 0.1)
    inp["c_g1"] = normal((nC, D, GATE_LORA), D ** -0.5)
    inp["c_g2"] = normal((nC, GATE_LORA, D), GATE_LORA ** -0.5)
    inp["c_k_k"] = 0.85 + normal((nC, D), 0.02)
    inp["c_k_a"] = 1.0 + normal((nC, D), 0.02)
    inp["c_r_k"] = normal((nC, RWKV_HEADS, RWKV_HEAD), 0.1)
    inp["c_lnx_g"] = 1.0 + normal((nC, D), 0.02)
    inp["c_lnx_b"] = normal((nC, D), 0.02)
    inp["c_w_out"] = normal((nC, D, D), D ** -0.5 * DEEPNORM_BETA)
    inp["x_w_q"] = normal((DEPTH, D, D), D ** -0.5)
    inp["x_w_kv"] = normal((DEPTH, D, 2 * D), D ** -0.5)
    inp["x_w_out"] = normal((DEPTH, D, D), D ** -0.5 * DEEPNORM_BETA)
    inp["m_w1"] = normal((DEPTH, D, D_FF), D ** -0.5)
    inp["m_w2"] = normal((DEPTH, D_FF, D), D_FF ** -0.5 * DEEPNORM_BETA)
    inp["ln_g"] = 1.0 + normal((DEPTH, 3, D), 0.02)
    inp["ln_b"] = normal((DEPTH, 3, D), 0.02)
    return inp


def reference(x, mem, rel_bias,
              a_w_in, a_b_in, a_dw, a_dw_b, a_ln_g, a_ln_b, a_w_out, a_b_out,
              b_w_qkv, b_w_out,
              c_mu, c_w_rkv, c_w0, c_w1, c_w2, c_a0, c_a1, c_a2, c_g1, c_g2,
              c_k_k, c_k_a, c_r_k, c_lnx_g, c_lnx_b, c_w_out,
              x_w_q, x_w_kv, x_w_out, m_w1, m_w2, ln_g, ln_b):
    for i in range(DEPTH):
        kind, j = i % N_MIXERS, i // N_MIXERS
        if kind == 0:
            h = conv_module(x, a_w_in[j], a_b_in[j], a_dw[j], a_dw_b[j], a_ln_g[j], a_ln_b[j],
                            a_w_out[j], a_b_out[j])
        elif kind == 1:
            h = dilated_attention(x, b_w_qkv[j], b_w_out[j], rel_bias)
        else:
            h = rwkv7_time_mix(x, c_mu[j], c_w_rkv[j], c_w0[j], c_w1[j], c_w2[j], c_a0[j],
                               c_a1[j], c_a2[j], c_g1[j], c_g2[j], c_k_k[j], c_k_a[j], c_r_k[j],
                               c_lnx_g[j], c_lnx_b[j], c_w_out[j])
        x = layer_norm(DEEPNORM_ALPHA * x + h, ln_g[i, 0], ln_b[i, 0])
        h = memory_cross_attention(x, mem, x_w_q[i], x_w_kv[i], x_w_out[i])
        x = layer_norm(DEEPNORM_ALPHA * x + h, ln_g[i, 1], ln_b[i, 1])
        h = sq_relu_mlp(x, m_w1[i], m_w2[i])
        x = layer_norm(DEEPNORM_ALPHA * x + h, ln_g[i, 2], ln_b[i, 2])
    return x
```

```cpp
#include <hip/hip_runtime.h>
#include <cstdio>
#include <cstdint>
#define ONE_LAUNCH 1
namespace pg8 {
#define PG8_LAS __attribute__((address_space(3)))
typedef unsigned short bf16_t;
typedef short bf16x8 __attribute__((ext_vector_type(8)));
typedef float f32x4 __attribute__((ext_vector_type(4)));
typedef unsigned u32x4 __attribute__((ext_vector_type(4)));
constexpr int BM = 256, BK = 64, HALF = 128, HTB = HALF * BK * 2  , STAGE_BYTES = 8 * HTB, NXCD = 8, WGM = 8;

__host__ __device__ __forceinline__ int lds_byte(int r, int c) { const int st = (r >> 4) * 2 + (c >> 5), rr = r & 15, cc = c & 31, ob = rr * 64 + cc * 2; return st * 1024 + (ob ^ (((ob >> 9) & 1) << 5)); }
__host__ __device__ __forceinline__ void stage_rc(int b, int& R, int& C) { const int st = b / 1024, sb = b % 1024, swz = sb ^ (((sb >> 9) & 1) << 5); R = (st >> 1) * 16 + swz / 64; C = (st & 1) * 32 + (swz % 64) / 2; }
__host__ __device__ __forceinline__ int perm32(int rho) { const int n = rho >> 4, i = rho & 15; return 8 * (i >> 2) + 4 * n + (i & 3); }

struct Unit { int pm, pn, tag; const char* a; const char* b; };
struct Gemm { int lda, ldb, K, ksplit; long kjump; };

struct Sched {
    int nM, nN, nwg, G, c, mode; const char* A; const char* B; long tA, tB; const char* memb; const char* wxkv;
    __device__ __forceinline__ bool next(int i, Unit& u) const {
        const long L = (long)i * G + c;
        if (mode == 3) {
            if (L >= 64) return false;
            const int layer = (int)L >> 4; int t = (int)L & 15;
            if (t < 8) { u.pm = t >> 2; u.pn = t & 3; u.a = memb + (long)u.pm * 524288; u.b = wxkv + (long)layer * 4194304 + (long)u.pn * 524288; u.tag = layer * 2; }
            else { t -= 8; u.pm = t >> 1; u.pn = t & 1; u.a = wxkv + (long)layer * 4194304 + (long)(4 + u.pm) * 524288; u.b = memb + (long)u.pn * 524288; u.tag = layer * 2 + 1; }
            return true;
        }
        if (L >= nwg) return false;
        int wgid = (int)L; { const int q = nwg / NXCD, r = nwg % NXCD, xcd = wgid % NXCD, off = wgid / NXCD; wgid = (xcd < r ? xcd * (q + 1) : r * (q + 1) + (xcd - r) * q) + off; }
        const int nig = WGM * nN, gid = wgid / nig, fm = gid * WGM, gsz = (nM - fm) < WGM ? (nM - fm) : WGM;
        u.pm = fm + ((wgid % nig) % gsz); u.pn = (wgid % nig) / gsz; u.tag = 0;
        if (mode == 0) { u.a = A + (long)u.pm * tA; u.b = B + (long)u.pn * tB; }
        else if (mode == 1) { u.a = A + (long)u.pm * 524288 + u.pn * 512; u.b = B + (long)(u.pm >> 5) * 524288 + u.pn * 512; }
        else { u.a = A + (long)u.pm * 524288 + u.pn * 512; u.b = B + (long)u.pn * 262144 + (u.pm >> 5) * 512; }
        return true;
    }
};

__device__ __forceinline__ unsigned cvt_pk_bf16(float lo, float hi) { unsigned r; asm volatile("v_cvt_pk_bf16_f32 %0, %1, %2" : "=v"(r) : "v"(lo), "v"(hi)); return r; }
__device__ __forceinline__ float sigm(float x) { return __builtin_amdgcn_rcpf(1.0f + __builtin_amdgcn_exp2f(-1.4426950408889634f * x)); }
__device__ __forceinline__ float tanh_f(float x) { return 1.0f - 2.0f * __builtin_amdgcn_rcpf(1.0f + __builtin_amdgcn_exp2f(2.8853900817779268f * x)); }
__device__ __forceinline__ float bflo(unsigned w) { return __uint_as_float(w << 16); }
__device__ __forceinline__ float bfhi(unsigned w) { return __uint_as_float(w & 0xffff0000u); }

enum { EM_PLAIN = 0, EM_RELU2 = 1, EM_GLU = 2, EM_RKV = 3, EM_L2A = 4, EM_KV = 5, EM_L2B = 6 };
struct EpiB {
    static constexpr bool PERM = true, AFTER_DRAIN = false;
    int mode; bf16_t* O; bf16_t* O2; int ldc; int split_cols; long split_stride; float scale0; const float* bias; const float* p0; const float* p1; bf16_t* kb; bf16_t* vt; bf16_t* Lb;
    __device__ __forceinline__ void operator()(const f32x4 (&acc)[2][2][4][2], const Unit& u, int wr, int wc, int fr, int fq) const {
        const int rowl = u.pm * BM + wr * 64 + fr, cl = wc * 32 + 8 * fq;
        if (mode == EM_GLU) {
            const int oc = u.pn * 128 + cl;
            f32x4 bv[2], bg[2];
#pragma unroll
            for (int n = 0; n < 2; ++n) { bv[n] = *(const f32x4*)(bias + oc + 4 * n); bg[n] = *(const f32x4*)(bias + 1024 + oc + 4 * n); }
#pragma unroll
            for (int ai = 0; ai < 2; ++ai)
#pragma unroll
                for (int m = 0; m < 4; ++m) {
                    float o[8];
#pragma unroll
                    for (int n = 0; n < 2; ++n)
#pragma unroll
                        for (int i = 0; i < 4; ++i) { const float v = acc[ai][0][m][n][i] + bv[n][i], g = acc[ai][1][m][n][i] + bg[n][i]; o[4 * n + i] = v * sigm(g); }
                    u32x4 w; w.x = cvt_pk_bf16(o[0], o[1]); w.y = cvt_pk_bf16(o[2], o[3]); w.z = cvt_pk_bf16(o[4], o[5]); w.w = cvt_pk_bf16(o[6], o[7]);
                    *(u32x4*)(O + (size_t)(rowl + ai * HALF + m * 16) * 1024 + oc) = w;
                }
            return;
        }
        bf16_t* base = O; int ld = ldc; int colt = u.pn * BM; float sc = 1.f; int tsel = 0;
        if (mode == EM_KV) { const int layer = u.tag >> 1; if (u.tag & 1) { base = vt + (size_t)layer * 524288; ld = 512; } else { base = kb + (size_t)layer * 524288; ld = 1024; } }
        else if (split_cols) { tsel = colt / split_cols; colt -= tsel * split_cols; if (tsel == 0) sc = scale0; else base = O2 + (size_t)(tsel - 1) * split_stride; }
        const bool lora = (mode == EM_RKV) && (u.pn == 12);
        if (lora) { base = Lb; ld = 256; colt = 0; sc = 1.f; }
#pragma unroll
        for (int ai = 0; ai < 2; ++ai)
#pragma unroll
            for (int m = 0; m < 4; ++m) {
                bf16_t* rowp = base + (size_t)(rowl + ai * HALF + m * 16) * ld + colt + cl;
#pragma unroll
                for (int bj = 0; bj < 2; ++bj) {
                    float o[8];
#pragma unroll
                    for (int n = 0; n < 2; ++n)
#pragma unroll
                        for (int i = 0; i < 4; ++i) o[4 * n + i] = acc[ai][bj][m][n][i] * sc;
                    if (mode == EM_RELU2) {
#pragma unroll
                        for (int i = 0; i < 8; ++i) { const float r = fmaxf(o[i], 0.f); o[i] = r * r; }
                    } else if (lora) {
                        const int c = bj * HALF + cl;
                        if (c < 64) {
#pragma unroll
                            for (int i = 0; i < 8; ++i) o[i] = tanh_f(o[i]);
                        } else if (c >= 128) {
#pragma unroll
                            for (int i = 0; i < 8; ++i) o[i] = sigm(o[i]);
                        }
                    } else if (mode == EM_L2A) {
                        const int gc = colt + bj * HALF + cl;
                        const float* pp = (tsel == 0 ? p0 : p1) + gc;
                        const f32x4 q0 = *(const f32x4*)pp, q1 = *(const f32x4*)(pp + 4);
                        const float mul = (tsel == 0) ? -0.6065306597126334f : 1.0f;
#pragma unroll
                        for (int i = 0; i < 4; ++i) { o[i] = mul * sigm(o[i] + q0[i]); o[4 + i] = mul * sigm(o[4 + i] + q1[i]); }
                    } else if (mode == EM_L2B) {
                        const u32x4 y = *(const u32x4*)(rowp + bj * HALF);
                        o[0] *= bflo(y.x); o[1] *= bfhi(y.x); o[2] *= bflo(y.y); o[3] *= bfhi(y.y); o[4] *= bflo(y.z); o[5] *= bfhi(y.z); o[6] *= bflo(y.w); o[7] *= bfhi(y.w);
                    }
                    u32x4 w; w.x = cvt_pk_bf16(o[0], o[1]); w.y = cvt_pk_bf16(o[2], o[3]); w.z = cvt_pk_bf16(o[4], o[5]); w.w = cvt_pk_bf16(o[6], o[7]);
                    *(u32x4*)(rowp + bj * HALF) = w;
                }
            }
    }
};
struct EpiResid {
    static constexpr bool PERM = false, AFTER_DRAIN = false;
    const float* base; float* out; const float* bias; float alpha;
    __device__ __forceinline__ void operator()(const f32x4 (&acc)[2][2][4][2], const Unit& u, int wr, int wc, int fr, int fq) const {
        const int col0 = u.pn * BM + wc * 32 + 4 * fq;
        f32x4 bv[2][2];
#pragma unroll
        for (int bj = 0; bj < 2; ++bj)
#pragma unroll
            for (int n = 0; n < 2; ++n) bv[bj][n] = bias ? *(const f32x4*)(bias + col0 + bj * HALF + n * 16) : (f32x4){0.f, 0.f, 0.f, 0.f};
#pragma unroll
        for (int ai = 0; ai < 2; ++ai)
#pragma unroll
            for (int m = 0; m < 4; ++m) {
                const size_t off = (size_t)(u.pm * BM + ai * HALF + wr * 64 + m * 16 + fr) * 1024 + col0;
#pragma unroll
                for (int bj = 0; bj < 2; ++bj)
#pragma unroll
                    for (int n = 0; n < 2; ++n) { const f32x4 bs = *(const f32x4*)(base + off + bj * HALF + n * 16); *(f32x4*)(out + off + bj * HALF + n * 16) = bs * alpha + acc[ai][bj][m][n] + bv[bj][n]; }
                if (m & 1) asm volatile("" ::: "memory");
            }
    }
};
struct EpiSoftmax {
    static constexpr bool PERM = true, AFTER_DRAIN = true;
    bf16_t* P;
    __device__ __forceinline__ void fused(f32x4 (&acc)[2][2][4][2], const Unit& u, int wr, int wc, int fr, int fq, PG8_LAS unsigned char* lds, int wid, int lane) const {
        PG8_LAS float* Pm = (PG8_LAS float*)lds; PG8_LAS float* Ps = Pm + 1024;
#pragma unroll
        for (int ai = 0; ai < 2; ++ai)
#pragma unroll
            for (int m = 0; m < 4; ++m) {
                float mx = -3.0e38f;
#pragma unroll
                for (int bj = 0; bj < 2; ++bj)
#pragma unroll
                    for (int n = 0; n < 2; ++n) { const f32x4 x = acc[ai][bj][m][n]; mx = fmaxf(mx, fmaxf(fmaxf(x[0], x[1]), fmaxf(x[2], x[3]))); }
                mx = fmaxf(mx, __shfl_xor(mx, 16)); mx = fmaxf(mx, __shfl_xor(mx, 32));
                if (fq == 0) Pm[(ai * HALF + wr * 64 + m * 16 + fr) * 4 + wc] = mx;
            }
        asm volatile("s_waitcnt lgkmcnt(0)" ::: "memory"); __builtin_amdgcn_s_barrier(); asm volatile("" ::: "memory");
#pragma unroll
        for (int ai = 0; ai < 2; ++ai)
#pragma unroll
            for (int m = 0; m < 4; ++m) {
                const int rl = ai * HALF + wr * 64 + m * 16 + fr;
                const f32x4 mm = *(const PG8_LAS f32x4*)(Pm + rl * 4);
                const float rm = fmaxf(fmaxf(mm[0], mm[1]), fmaxf(mm[2], mm[3]));
                float s = 0.f;
#pragma unroll
                for (int bj = 0; bj < 2; ++bj)
#pragma unroll
                    for (int n = 0; n < 2; ++n)
#pragma unroll
                        for (int i = 0; i < 4; ++i) { const float e = __builtin_amdgcn_exp2f(acc[ai][bj][m][n][i] - rm); acc[ai][bj][m][n][i] = e; s += e; }
                s += __shfl_xor(s, 16); s += __shfl_xor(s, 32);
                if (fq == 0) Ps[rl * 4 + wc] = s;
            }
        asm volatile("s_waitcnt lgkmcnt(0)" ::: "memory"); __builtin_amdgcn_s_barrier(); asm volatile("" ::: "memory");
#pragma unroll
        for (int ai = 0; ai < 2; ++ai)
#pragma unroll
            for (int m = 0; m < 4; ++m) {
                const int rl = ai * HALF + wr * 64 + m * 16 + fr;
                const f32x4 ss = *(const PG8_LAS f32x4*)(Ps + rl * 4);
                const float inv = 1.0f / ((ss[0] + ss[1]) + (ss[2] + ss[3]));
                bf16_t* rowp = P + (size_t)(u.pm * BM + rl) * 1024 + u.pn * BM + wc * 32 + 8 * fq;
#pragma unroll
                for (int bj = 0; bj < 2; ++bj) {
                    const f32x4 v0 = acc[ai][bj][m][0] * inv, v1 = acc[ai][bj][m][1] * inv;
                    u32x4 w; w.x = cvt_pk_bf16(v0[0], v0[1]); w.y = cvt_pk_bf16(v0[2], v0[3]); w.z = cvt_pk_bf16(v1[0], v1[1]); w.w = cvt_pk_bf16(v1[2], v1[3]);
                    *(u32x4*)(rowp + bj * HALF) = w;
                }
            }
    }
};

template <class Epi, bool ALIGN_EPI>
__device__ __forceinline__ void gemm_phase(PG8_LAS unsigned char* lds, const Gemm g, const Sched& S, const Epi& E, const int tid) {
    const int wid = __builtin_amdgcn_readfirstlane(tid >> 6), lane = tid & 63, wr = wid >> 2, wc = wid & 3, fr = lane & 15, fq = lane >> 4;
    const int K = g.K, nt = K / BK;
    unsigned voffA[2], voffB[2];
#pragma unroll
    for (int i = 0; i < 2; ++i) { int R, C; stage_rc(tid * 16 + i * 8192, R, C); const int Rb = Epi::PERM ? ((R & ~31) + perm32(R & 31)) : R;
        voffA[i] = (unsigned)(R * g.lda + C) * 2u; voffB[i] = (unsigned)(Rb * g.ldb + C) * 2u; }
    const size_t kstep = (size_t)(BK * 2);
    const size_t hA = (size_t)HALF * g.lda * 2, hB = (size_t)HALF * g.ldb * 2;
    const unsigned ldsw = (unsigned)wid * 1024u;
    const int aoff = lds_byte(wr * 64 + fr, fq * 8), boff = lds_byte(wc * 32 + fr, fq * 8);
    const int ksplit = g.ksplit; const long kjump = g.kjump;
#define PG8_KA(base, t) ((base) + (size_t)(t) * kstep + ((t) >= ksplit ? kjump : 0l))
#define PG8_SA(b, h) (((b) * 2 + (h)) * HTB)
#define PG8_SB(b, h) ((4 + (b) * 2 + (h)) * HTB)
#define PG8_STAGE(bufoff, gbase, voff) do { _Pragma("unroll") for (int _i = 0; _i < 2; ++_i) \
        __builtin_amdgcn_global_load_lds((const unsigned*)((const char*)(gbase) + (voff)[_i]), (PG8_LAS unsigned*)(lds + (bufoff) + ldsw + _i * 8192), 16, 0, 0); } while (0)
#define PG8_LDA(dst, b, h) do { _Pragma("unroll") for (int m = 0; m < 4; ++m) _Pragma("unroll") for (int k = 0; k < 2; ++k) dst[m][k] = *(const PG8_LAS bf16x8*)(lds + PG8_SA(b, h) + aoff + m * 2048 + k * 1024); } while (0)
#define PG8_LDB(dst, b, h) do { _Pragma("unroll") for (int n = 0; n < 2; ++n) _Pragma("unroll") for (int k = 0; k < 2; ++k) dst[n][k] = *(const PG8_LAS bf16x8*)(lds + PG8_SB(b, h) + boff + n * 2048 + k * 1024); } while (0)
#define PG8_MMA(ai, bj, At, Bt) do { __builtin_amdgcn_s_setprio(1); _Pragma("unroll") for (int m = 0; m < 4; ++m) _Pragma("unroll") for (int n = 0; n < 2; ++n) _Pragma("unroll") for (int k = 0; k < 2; ++k) \
        acc[ai][bj][m][n] = __builtin_amdgcn_mfma_f32_16x16x32_bf16(Bt[n][k], At[m][k], acc[ai][bj][m][n], 0, 0, 0); __builtin_amdgcn_s_setprio(0); } while (0)
#define PG8_WAIT_V(n) asm volatile("s_waitcnt vmcnt(" #n ")" ::: "memory")
#define PG8_WAIT_L(n) asm volatile("s_waitcnt lgkmcnt(" #n ")" ::: "memory")
#define PG8_BAR __builtin_amdgcn_s_barrier()
#define PG8_SCHED __builtin_amdgcn_sched_barrier(0)
    Unit cur, nxt; int ui = 0;
    if (!S.next(0, cur)) return;
    f32x4 acc[2][2][4][2];
#pragma unroll
    for (int a = 0; a < 2; ++a)
#pragma unroll
        for (int b = 0; b < 2; ++b)
#pragma unroll
            for (int m = 0; m < 4; ++m)
#pragma unroll
                for (int n = 0; n < 2; ++n) acc[a][b][m][n] = (f32x4){0.f, 0.f, 0.f, 0.f};
    bf16x8 At[4][2], B0[2][2], B1[2][2];
    const char* cA = cur.a; const char* cB = cur.b;
    PG8_STAGE(PG8_SB(0, 0), cB, voffB); PG8_STAGE(PG8_SB(0, 1), cB + hB, voffB); PG8_STAGE(PG8_SA(0, 0), cA, voffA); PG8_STAGE(PG8_SA(0, 1), cA + hA, voffA);
    if (wr == 1) PG8_BAR;
    PG8_WAIT_V(2); PG8_BAR;
    PG8_STAGE(PG8_SB(1, 0), cB + kstep, voffB); PG8_STAGE(PG8_SA(1, 0), PG8_KA(cA, 1), voffA); PG8_STAGE(PG8_SB(1, 1), cB + hB + kstep, voffB);
    PG8_WAIT_V(6); PG8_BAR;
    for (;;) {
        const bool has_next = S.next(ui + 1, nxt);
        const char* nA = has_next ? nxt.a : cA; const char* nB = has_next ? nxt.b : cB;
        for (int t = 0; t < nt; t += 2) {
            const bool last = (t == nt - 2);
            const char* a1 = PG8_KA(cA, t + 1);
            const char* a2 = last ? nA : PG8_KA(cA, t + 2); const char* b2 = last ? nB : cB + (size_t)(t + 2) * kstep;
            const char* a3 = last ? nA + kstep : PG8_KA(cA, t + 3); const char* b3 = b2 + kstep;
            PG8_LDB(B0, 0, 0); PG8_LDB(B1, 0, 1); PG8_SCHED; PG8_LDA(At, 0, 0); PG8_STAGE(PG8_SA(1, 1), a1 + hA, voffA);
            PG8_WAIT_V(8); PG8_WAIT_L(0); PG8_BAR; PG8_MMA(0, 0, At, B0); PG8_MMA(0, 1, At, B1); PG8_BAR; PG8_SCHED;
            PG8_LDA(At, 0, 1); PG8_STAGE(PG8_SB(0, 0), b2, voffB); PG8_STAGE(PG8_SB(0, 1), b2 + hB, voffB); PG8_STAGE(PG8_SA(0, 0), a2, voffA);
            PG8_WAIT_V(8); PG8_WAIT_L(0); PG8_BAR; PG8_MMA(1, 0, At, B0); PG8_MMA(1, 1, At, B1); PG8_BAR; PG8_SCHED;
            PG8_LDB(B0, 1, 0); PG8_LDB(B1, 1, 1); PG8_SCHED; PG8_LDA(At, 1, 0); PG8_STAGE(PG8_SA(0, 1), a2 + hA, voffA);
            PG8_WAIT_V(8); PG8_WAIT_L(0); PG8_BAR; PG8_MMA(0, 0, At, B0); PG8_MMA(0, 1, At, B1); PG8_BAR; PG8_SCHED;
            PG8_LDA(At, 1, 1); PG8_STAGE(PG8_SB(1, 0), b3, voffB); PG8_STAGE(PG8_SB(1, 1), b3 + hB, voffB); PG8_STAGE(PG8_SA(1, 0), a3, voffA);
            PG8_WAIT_V(8); PG8_WAIT_L(0); PG8_BAR; PG8_MMA(1, 0, At, B0); PG8_MMA(1, 1, At, B1); PG8_BAR; PG8_SCHED;
        }
        if constexpr (ALIGN_EPI) { if (wr == 0) PG8_BAR; }
        if constexpr (!Epi::AFTER_DRAIN) { E(acc, cur, wr, wc, fr, fq); }
        if (!has_next) break;
#pragma unroll
        for (int a = 0; a < 2; ++a)
#pragma unroll
            for (int b = 0; b < 2; ++b)
#pragma unroll
                for (int m = 0; m < 4; ++m)
#pragma unroll
                    for (int n = 0; n < 2; ++n) acc[a][b][m][n] = (f32x4){0.f, 0.f, 0.f, 0.f};
        cur = nxt; cA = nA; cB = nB; ++ui;
        if constexpr (ALIGN_EPI) { if (wr == 1) PG8_BAR; }
    }
    PG8_WAIT_V(0);
    if constexpr (!ALIGN_EPI) { if (wr == 0) PG8_BAR; }
    PG8_BAR;
    if constexpr (Epi::AFTER_DRAIN) { E.fused(acc, cur, wr, wc, fr, fq, lds, wid, lane); }
#undef PG8_KA
#undef PG8_SA
#undef PG8_SB
#undef PG8_STAGE
#undef PG8_LDA
#undef PG8_LDB
#undef PG8_MMA
#undef PG8_WAIT_V
#undef PG8_WAIT_L
#undef PG8_BAR
#undef PG8_SCHED
}
}
constexpr int NWAVES = 8;
constexpr int BATCH = 2, SEQ = 8192, D = 1024, M = BATCH * SEQ, FF = 4096, DEPTH = 4;
constexpr float ALPHA = 1.6817928305074290f;
constexpr float LN_EPS = 1e-5f, GN_EPS = 64e-5f;
constexpr float LOG2E = 1.4426950408889634f, LN2 = 0.6931471805599453f;

constexpr size_t MiB = 1u << 20;
constexpr size_t WS_CTL = 0, CTL_ZERO_BYTES = 1 * MiB;
constexpr size_t WS_TAB = 1 * MiB;
constexpr size_t WS_LSE = 2 * MiB;
constexpr size_t WS_MEMB = 5 * MiB;
constexpr size_t WS_KB = 6 * MiB;
constexpr size_t WS_VT = 10 * MiB;
constexpr size_t WS_L = 14 * MiB;
constexpr size_t WS_XB = 22 * MiB;
constexpr size_t WS_WA = 54 * MiB;
constexpr size_t WS_WB = 80 * MiB;
constexpr size_t WS_WC = 120 * MiB;
constexpr size_t WS_SCR = 157 * MiB;
constexpr size_t SLOT = 32 * MiB;
constexpr size_t WS_END = 317 * MiB;
constexpr int CW_TMO = 0, CW_CODE = 1, CW_BAR = 4096;

constexpr int RING_OFF = 0, RING_BYTES = 131072;
constexpr int LDSCTL_OFF = RING_BYTES, MISC_OFF = LDSCTL_OFF + 320, XTRA_OFF = RING_BYTES + 1024;
constexpr int LDS_BYTES = 147456;

#define GAS __attribute__((address_space(1)))
#define LAS __attribute__((address_space(3)))
typedef unsigned short bf16;
typedef unsigned v4u __attribute__((ext_vector_type(4)));
typedef unsigned v2u __attribute__((ext_vector_type(2)));
typedef float f32x4 __attribute__((ext_vector_type(4)));
typedef float f32x2 __attribute__((ext_vector_type(2)));
typedef float f32x16 __attribute__((ext_vector_type(16)));
typedef short bf16x8 __attribute__((ext_vector_type(8)));
typedef short s16x4 __attribute__((ext_vector_type(4)));
typedef GAS unsigned gu32;
#define RLX_AGENT __ATOMIC_RELAXED, __HIP_MEMORY_SCOPE_AGENT
#define LDS_WAIT() asm volatile("s_waitcnt lgkmcnt(0)" ::: "memory")
#define VM_WAIT() asm volatile("s_waitcnt vmcnt(0)" ::: "memory")
__device__ __forceinline__ unsigned f2bf(float f) { unsigned u = __builtin_bit_cast(unsigned, f); return (u + 0x7fffu + ((u >> 16) & 1u)) >> 16; }
__device__ __forceinline__ unsigned pk2(float lo, float hi) { return f2bf(lo) | (f2bf(hi) << 16); }
__device__ __forceinline__ float bf2f(unsigned short b) { return __uint_as_float((unsigned)b << 16); }
__device__ __forceinline__ float bflo(unsigned w) { return __uint_as_float(w << 16); }
__device__ __forceinline__ float bfhi(unsigned w) { return __uint_as_float(w & 0xffff0000u); }
__device__ __forceinline__ float wave_sum(float v) {
#pragma unroll
    for (int o = 1; o < 64; o <<= 1) v += __shfl_xor(v, o);
    return v;
}
__device__ __forceinline__ float sigm(float x) { return __builtin_amdgcn_rcpf(1.0f + __builtin_amdgcn_exp2f(-LOG2E * x)); }

#define XB_TMO      128
#define XB_XCNT(j)  (256  + 64 * (j))
#define XB_XSUB(j)  (1280 + 64 * (j))
#define XB_XGEN(j)  (2304 + 64 * (j))
#define XB_TOP      3328
#define XB_TOPGEN   3392
#define XCD_BAR_WORDS 3456
#define XB_SPIN_CAP (1u << 18)
__device__ __forceinline__ unsigned xb_ld(unsigned* p)              { return __hip_atomic_load(p, __ATOMIC_RELAXED, __HIP_MEMORY_SCOPE_AGENT); }
__device__ __forceinline__ unsigned xb_add(unsigned* p, unsigned v) { return __hip_atomic_fetch_add(p, v, __ATOMIC_RELAXED, __HIP_MEMORY_SCOPE_AGENT); }
__device__ __forceinline__ unsigned xb_xcc_id() { return (unsigned)__builtin_amdgcn_s_getreg((3 << 11) | 20) & 0xFu; }
#define XB_SPIN(cond, bar) do { unsigned _sp = 0; while (cond) { __builtin_amdgcn_s_sleep(1); \
    if ((++_sp & 255u) == 0u) { if (xb_ld(&(bar)[XB_TMO])) break; if (_sp > XB_SPIN_CAP) { atomicAdd(&(bar)[XB_TMO], 1u); break; } } } } while (0)
struct XcdBarrier { unsigned* bar; unsigned x; volatile LAS unsigned* st; };
__device__ __forceinline__ XcdBarrier xcd_barrier_post(unsigned* bar, volatile LAS unsigned* st, int tid) {
    XcdBarrier b; b.bar = bar; b.x = xb_xcc_id(); b.st = st;
    if (tid == 0) (void)xb_add(&bar[XB_XCNT(b.x)], 1u);
    return b;
}
__device__ __forceinline__ void xcd_barrier_complete(unsigned* bar, unsigned x, unsigned& nloc, unsigned& nx) {
    const unsigned G = gridDim.x * gridDim.y * gridDim.z;
    unsigned sum, cnt, mine, sp = 0u;
    for (;;) {
        sum = 0u; cnt = 0u; mine = 0u;
#pragma unroll
        for (unsigned j = 0; j < 16; ++j) { const unsigned c = xb_ld(&bar[XB_XCNT(j)]); sum += c; cnt += (c > 0u) ? 1u : 0u; mine = (j == x) ? c : mine; }
        if (sum == G) break;
        __builtin_amdgcn_s_sleep(1);
        if ((++sp & 255u) == 0u) { if (xb_ld(&bar[XB_TMO])) break; if (sp > XB_SPIN_CAP) { atomicAdd(&bar[XB_TMO], 1u); break; } }
    }
    nloc = mine > 0u ? mine : 1u; nx = cnt > 0u ? cnt : 1u;
}
__device__ __forceinline__ void xcd_barrier(const XcdBarrier& b, int tid) {
    asm volatile("s_waitcnt vmcnt(0)" ::: "memory");
    __syncthreads();
    if (tid == 0) {
        unsigned* bar = b.bar;
        __builtin_amdgcn_s_waitcnt(0);
        unsigned nloc = b.st[0], nx = b.st[1];
        if (nloc == 0u) { xcd_barrier_complete(bar, b.x, nloc, nx); b.st[0] = nloc; b.st[1] = nx; }
        const unsigned old = xb_add(&bar[XB_XSUB(b.x)], 1u);
        const unsigned gen = old / nloc;
        if (old + 1u == (gen + 1u) * nloc) {
            __builtin_amdgcn_fence(__ATOMIC_RELEASE, "agent");
            asm volatile("s_waitcnt vmcnt(0)" ::: "memory");
            const unsigned og = xb_add(&bar[XB_TOP], 1u);
            const unsigned tg = og / nx;
            if (og + 1u == (tg + 1u) * nx) xb_add(&bar[XB_TOPGEN], 1u);
            else XB_SPIN(xb_ld(&bar[XB_TOPGEN]) == tg, bar);
            __builtin_amdgcn_fence(__ATOMIC_ACQUIRE, "agent");
            xb_add(&bar[XB_XGEN(b.x)], 1u);
            asm volatile("s_waitcnt vmcnt(0)" ::: "memory");
        } else {
            XB_SPIN(xb_ld(&bar[XB_XGEN(b.x)]) == gen, bar);
            __builtin_amdgcn_fence(__ATOMIC_ACQUIRE, "agent");
            asm volatile("s_waitcnt vmcnt(0)" ::: "memory");
        }
    }
    __syncthreads();
}

struct Args { const float* in[36]; float* out; unsigned char* ws; int ph_lo, ph_hi; };

#define CAS __attribute__((address_space(4)))
struct KArgs {
    const char CAS* p;
    __device__ __forceinline__ const float* in(int i) const { return *(const float* const CAS*)(p + 8 * i); }
    __device__ __forceinline__ float* out() const { return *(float* const CAS*)(p + 288); }
    __device__ __forceinline__ unsigned char* ws() const { return *(unsigned char* const CAS*)(p + 296); }
    __device__ __forceinline__ int ph_lo() const { return *(const int CAS*)(p + 304); }
    __device__ __forceinline__ int ph_hi() const { return *(const int CAS*)(p + 308); }
};
struct Frame {
    LAS unsigned char* lds;
    int tid, lane, wave, vcu, G;
    KArgs a;
};
__device__ __forceinline__ void tr_item(const float* W, int ldw, int k0, int n0, bf16* WT, int ldt, int drow0, int kd0, LAS float* scr, int lane, const float* mu) {
#pragma unroll 8
    for (int i = 0; i < 32; ++i) { const int kk = 2 * i + (lane >> 5); scr[kk * 33 + (lane & 31)] = W[(size_t)(k0 + kk) * ldw + n0 + (lane & 31)]; }
    LDS_WAIT(); asm volatile("" ::: "memory");
    const int c = lane & 7;
    float m8[8];
    if (mu) {
#pragma unroll
        for (int i = 0; i < 8; ++i) m8[i] = mu[k0 + 8 * c + i];
    }
#pragma unroll
    for (int j = 0; j < 4; ++j) { const int n = (lane >> 3) + 8 * j; const LAS float* s = scr + (8 * c) * 33 + n;
        float v[8];
#pragma unroll
        for (int i = 0; i < 8; ++i) v[i] = s[i * 33];
        bf16* dst = WT + (size_t)(drow0 + n) * ldt + kd0 + 8 * c;
        if (mu) {
            v4u o, p;
            o.x = pk2(v[0] * (1.f - m8[0]), v[1] * (1.f - m8[1])); o.y = pk2(v[2] * (1.f - m8[2]), v[3] * (1.f - m8[3])); o.z = pk2(v[4] * (1.f - m8[4]), v[5] * (1.f - m8[5])); o.w = pk2(v[6] * (1.f - m8[6]), v[7] * (1.f - m8[7]));
            p.x = pk2(v[0] * m8[0], v[1] * m8[1]); p.y = pk2(v[2] * m8[2], v[3] * m8[3]); p.z = pk2(v[4] * m8[4], v[5] * m8[5]); p.w = pk2(v[6] * m8[6], v[7] * m8[7]);
            *(GAS v4u*)dst = o; *(GAS v4u*)(dst + 1024) = p;
        } else {
            v4u o; o.x = pk2(v[0], v[1]); o.y = pk2(v[2], v[3]); o.z = pk2(v[4], v[5]); o.w = pk2(v[6], v[7]);
            *(GAS v4u*)dst = o;
        }
    }
    LDS_WAIT(); asm volatile("" ::: "memory");
}
__device__ __forceinline__ void zero_item(bf16* WT, int ldt, int drow0, int kd0, int lane) {
    const int c = lane & 7;
#pragma unroll
    for (int j = 0; j < 4; ++j) { const int n = (lane >> 3) + 8 * j; *(GAS v4u*)(WT + (size_t)(drow0 + n) * ldt + kd0 + 8 * c) = (v4u){0u, 0u, 0u, 0u}; }
}
__device__ __forceinline__ void cvt_row(const float* xrow, bf16* orow, int lane) {
    const GAS f32x4* xr = (const GAS f32x4*)xrow + lane; GAS unsigned long long* o8 = (GAS unsigned long long*)orow + lane;
#pragma unroll
    for (int j = 0; j < 4; ++j) { const f32x4 v = xr[64 * j]; o8[64 * j] = (unsigned long long)pk2(v.x, v.y) | ((unsigned long long)pk2(v.z, v.w) << 32); }
}
struct TJob { const float* W; int ldw, N; bf16* WT; int ldt, drow_off, rowmode; const float* mu; };
__device__ __forceinline__ void run_job(const TJob& J, int r, LAS float* scr, int lane) {
    const int nblk = J.N / 32, kb = r / nblk, nb = r % nblk, n0 = 32 * nb;
    int drow0 = n0;
    if (J.rowmode == 1) { const int g = n0 >= 1024, nn = n0 - g * 1024; drow0 = (nn >> 7) * 256 + g * 128 + (nn & 127); }
    tr_item(J.W, J.ldw, 64 * kb, n0, J.WT, J.ldt, J.drow_off + drow0, 64 * kb, scr, lane, J.mu);
}
#define WSB(off) ((bf16*)(ws + (off)))
__device__ __forceinline__ size_t lw_base(int l) { return l == 1 ? WS_WB : (l == 2 ? WS_WC : WS_WA); }
__device__ __forceinline__ size_t lw_xq(int l) { return lw_base(l) + (l == 1 ? 20 : (l == 2 ? 17 : 6)) * MiB; }

__device__ __forceinline__ bool tail_jobs(const KArgs A, unsigned char* ws, int l, int& r, TJob& J) {
    const size_t xq = lw_xq(l);
    if (r < 512) { J = TJob{A.in(29) + (size_t)l * D * D, D, D, WSB(xq), D, 0, 0, nullptr}; return true; } r -= 512;
    if (r < 512) { J = TJob{A.in(31) + (size_t)l * D * D, D, D, WSB(xq + 2 * MiB), D, 0, 0, nullptr}; return true; } r -= 512;
    if (r < 2048) { J = TJob{A.in(32) + (size_t)l * D * FF, FF, FF, WSB(xq + 4 * MiB), D, 0, 0, nullptr}; return true; } r -= 2048;
    if (r < 2048) { J = TJob{A.in(33) + (size_t)l * FF * D, D, D, WSB(xq + 12 * MiB), FF, 0, 0, nullptr}; return true; } r -= 2048;
    return false;
}
__device__ __forceinline__ bool conv_jobs(const KArgs A, unsigned char* ws, int j, int& r, TJob& J) {
    if (r < 1024) { J = TJob{A.in(3) + (size_t)j * D * 2 * D, 2 * D, 2 * D, WSB(WS_WA), D, 0, 1, nullptr}; return true; } r -= 1024;
    if (r < 512) { J = TJob{A.in(9) + (size_t)j * D * D, D, D, WSB(WS_WA + 4 * MiB), D, 0, 0, nullptr}; return true; } r -= 512;
    return false;
}
constexpr int PROA_ITEMS = (1536 + 5120) + (4608 + 512 + 5120) + (1536 + 32 + 32 + 64 + 384 + 512 + 5120) + 4 * 1024;
constexpr int PROB_ITEMS = 1536 + 5120;
__device__ __forceinline__ void pro_phase(Frame& F, int which) {
    const KArgs A = F.a; unsigned char* ws = A.ws();
    LAS float* scr = (LAS float*)(F.lds + RING_OFF + F.wave * 16384);
    const int gw = F.vcu * NWAVES + F.wave, NGW = F.G * NWAVES, lane = F.lane;
    const int nitems = which == 0 ? PROA_ITEMS : PROB_ITEMS;
    for (int it = gw; it < nitems; it += NGW) {
        int r = it; TJob J;
        if (which == 1) {
            if (!conv_jobs(A, ws, 1, r, J)) tail_jobs(A, ws, 3, r, J);
            run_job(J, r, scr, lane); continue;
        }
        if (conv_jobs(A, ws, 0, r, J) || tail_jobs(A, ws, 0, r, J)) { run_job(J, r, scr, lane); continue; }
        if (r < 4608) { J = TJob{A.in(11), 9216, 9216, WSB(WS_WB), D, 0, 0, nullptr}; run_job(J, r, scr, lane); continue; } r -= 4608;
        if (r < 512) { J = TJob{A.in(12), D, D, WSB(WS_WB + 18 * MiB), D, 0, 0, nullptr}; run_job(J, r, scr, lane); continue; } r -= 512;
        if (tail_jobs(A, ws, 1, r, J)) { run_job(J, r, scr, lane); continue; }
        if (r < 1536) { const int s = r / 512; J = TJob{A.in(14) + (size_t)s * D * D, D, D, WSB(WS_WC), 2 * D, s * 1024, 0, A.in(13) + s * D}; run_job(J, r % 512, scr, lane); continue; } r -= 1536;
        if (r < 32) { J = TJob{A.in(16), 64, 64, WSB(WS_WC), 2 * D, 3072, 0, A.in(13) + 3 * D}; run_job(J, r, scr, lane); continue; } r -= 32;
        if (r < 32) { J = TJob{A.in(19), 64, 64, WSB(WS_WC), 2 * D, 3136, 0, A.in(13) + 4 * D}; run_job(J, r, scr, lane); continue; } r -= 32;
        if (r < 64) { J = TJob{A.in(21), 128, 128, WSB(WS_WC), 2 * D, 3200, 0, A.in(13) + 5 * D}; run_job(J, r, scr, lane); continue; } r -= 64;
        if (r < 384) {
            const int kb = r / 96, nb = r % 96, n0 = 32 * nb, mat = n0 >> 10;
            bf16* WT = WSB(WS_WC + 13 * MiB);
            const bool inband = (mat == 0 && kb == 0) || (mat == 1 && kb == 1) || (mat == 2 && kb >= 2);
            if (inband) { const float* src = mat == 0 ? A.in(17) : (mat == 1 ? A.in(20) : A.in(22)); const int ks = mat == 2 ? 64 * (kb - 2) : 0;
                tr_item(src, D, ks, n0 & 1023, WT, 256, n0, 64 * kb, scr, lane, nullptr); }
            else zero_item(WT, 256, n0, 64 * kb, lane);
            continue; } r -= 384;
        if (r < 512) { J = TJob{A.in(28), D, D, WSB(WS_WC + 15 * MiB), D, 0, 0, nullptr}; run_job(J, r, scr, lane); continue; } r -= 512;
        if (tail_jobs(A, ws, 2, r, J)) { run_job(J, r, scr, lane); continue; }
        { const int l = r / 1024; J = TJob{A.in(30) + (size_t)l * D * 2 * D, 2 * D, 2 * D, WSB(WS_SCR + 4 * SLOT + (size_t)l * 4 * MiB), D, 0, 0, nullptr}; run_job(J, r % 1024, scr, lane); }
    }
    if (which == 0) {
        for (int m = gw; m < M; m += NGW) cvt_row(A.in(0) + (size_t)m * D, WSB(WS_XB) + (size_t)m * D, lane);
        for (int m = gw; m < 512; m += NGW) cvt_row(A.in(1) + (size_t)m * D, WSB(WS_MEMB) + (size_t)m * D, lane);
        float* tab = (float*)(ws + WS_TAB);
        for (int e = (F.vcu * NWAVES + F.wave) * 64 + lane; e < 3 * 16 * 129; e += NGW * 64) {
            const int g = e / (16 * 129), h = (e / 129) % 16, rel = e % 129;
            const int n = rel * (g == 0 ? 1 : (g == 1 ? 4 : 16));
            int bk = n;
            if (n >= 16) { const float v = logf((float)n / 16.0f) / 4.852030263919617f * 16.0f; bk = 16 + (int)v; if (bk > 31) bk = 31; }
            tab[e] = A.in(2)[bk * 16 + h] * LOG2E;
        }
    }
}

__device__ __forceinline__ void ln_phase(Frame& F, const float* g, const float* b, int write_xs) {
    const KArgs A = F.a; unsigned char* ws = A.ws(); const int lane = F.lane;
    const int gw = F.vcu * NWAVES + F.wave, NGW = F.G * NWAVES;
    f32x4 gv[4], bv[4];
#pragma unroll
    for (int j = 0; j < 4; ++j) { gv[j] = ((const f32x4*)g)[lane + 64 * j]; bv[j] = ((const f32x4*)b)[lane + 64 * j]; }
    bf16* XB = WSB(WS_XB); bf16* XS = WSB(WS_SCR + 4 * SLOT);
    for (int m = gw; m < M; m += NGW) {
        GAS f32x4* xr = (GAS f32x4*)(A.out() + (size_t)m * D) + lane;
        f32x4 v[4]; float s = 0.f;
#pragma unroll
        for (int j = 0; j < 4; ++j) { v[j] = xr[64 * j]; s += (v[j].x + v[j].y) + (v[j].z + v[j].w); }
        const float mean = wave_sum(s) * (1.f / D); float s2 = 0.f;
#pragma unroll
        for (int j = 0; j < 4; ++j) { v[j] = v[j] - mean; s2 += (v[j].x * v[j].x + v[j].y * v[j].y) + (v[j].z * v[j].z + v[j].w * v[j].w); }
        const float rstd = 1.f / sqrtf(wave_sum(s2) * (1.f / D) + LN_EPS);
        GAS unsigned long long* o8 = (GAS unsigned long long*)(XB + (size_t)m * D) + lane;
        GAS unsigned long long* s8 = (GAS unsigned long long*)(XS + (size_t)(m + 1) * D) + lane;
        const bool sh = write_xs && ((m + 1) % SEQ != 0);
#pragma unroll
        for (int j = 0; j < 4; ++j) {
            const f32x4 o = v[j] * rstd * gv[j] + bv[j];
            xr[64 * j] = o;
            const unsigned long long pk = (unsigned long long)pk2(o.x, o.y) | ((unsigned long long)pk2(o.z, o.w) << 32);
            o8[64 * j] = pk;
            if (sh) s8[64 * j] = pk;
        }
        if (write_xs && (m % SEQ == 0)) {
            GAS unsigned long long* z8 = (GAS unsigned long long*)(XS + (size_t)m * D) + lane;
#pragma unroll
            for (int j = 0; j < 4; ++j) z8[64 * j] = 0ull;
        }
    }
}

constexpr int CT = 16;
__device__ __forceinline__ void conv_phase(Frame& F, const bf16* U, bf16* C1, const float* dw, const float* dwb, const float* lg, const float* lb) {
    const int tid = F.tid, c0 = 2 * tid, lane = F.lane, wave = F.wave;
    LAS float* red = (LAS float*)(F.lds + RING_OFF);
    float dwr[31][2];
#pragma unroll
    for (int j = 0; j < 31; ++j) { const f32x2 t = *(const f32x2*)(dw + j * D + c0); dwr[j][0] = t.x; dwr[j][1] = t.y; }
    const f32x2 bb = *(const f32x2*)(dwb + c0), gg = *(const f32x2*)(lg + c0), lbb = *(const f32x2*)(lb + c0);
    for (int tile = F.vcu; tile < M / CT; tile += F.G) {
        const int b = tile / (SEQ / CT), t0 = (tile % (SEQ / CT)) * CT;
        float out[CT][2];
#pragma unroll
        for (int o = 0; o < CT; ++o) { out[o][0] = bb.x; out[o][1] = bb.y; }
#pragma unroll
        for (int i = 0; i < CT + 30; ++i) {
            const int t = t0 - 30 + i;
            unsigned w = 0u;
            if (t >= 0) w = *(const unsigned*)(U + (size_t)(b * SEQ + t) * D + c0);
            const float x0 = bflo(w), x1 = bfhi(w);
#pragma unroll
            for (int o = (i > 30 ? i - 30 : 0); o <= (i < CT ? i : CT - 1); ++o) { out[o][0] += x0 * dwr[i - o][0]; out[o][1] += x1 * dwr[i - o][1]; }
            if ((i & 7) == 7) asm volatile("" ::: "memory");
        }
        __syncthreads();
#pragma unroll
        for (int o = 0; o < CT; ++o) { const float s = wave_sum(out[o][0] + out[o][1]); if (lane == 0) red[o * 8 + wave] = s; }
        __syncthreads();
#pragma unroll
        for (int o = 0; o < CT; ++o) { const f32x4 a = *(const LAS f32x4*)(red + o * 8), c = *(const LAS f32x4*)(red + o * 8 + 4); const float mean = ((a.x + a.y) + (a.z + a.w) + (c.x + c.y) + (c.z + c.w)) * (1.f / D); out[o][0] -= mean; out[o][1] -= mean; }
        __syncthreads();
#pragma unroll
        for (int o = 0; o < CT; ++o) { const float s = wave_sum(out[o][0] * out[o][0] + out[o][1] * out[o][1]); if (lane == 0) red[o * 8 + wave] = s; }
        __syncthreads();
#pragma unroll
        for (int o = 0; o < CT; ++o) {
            const f32x4 a = *(const LAS f32x4*)(red + o * 8), c = *(const LAS f32x4*)(red + o * 8 + 4);
            const float rstd = 1.f / sqrtf(((a.x + a.y) + (a.z + a.w) + (c.x + c.y) + (c.z + c.w)) * (1.f / D) + LN_EPS);
            const float y0 = out[o][0] * rstd * gg.x + lbb.x, y1 = out[o][1] * rstd * gg.y + lbb.y;
            *(unsigned*)(C1 + (size_t)(b * SEQ + t0 + o) * D + c0) = pk2(y0 * sigm(y0), y1 * sigm(y1));
        }
    }
    __syncthreads();
}

__device__ __forceinline__ void combine_phase(Frame& F) {
    const KArgs A = F.a; unsigned char* ws = A.ws(); const int lane = F.lane;
    const int gw = F.vcu * NWAVES + F.wave, NGW = F.G * NWAVES;
    const float* lse = (const float*)(ws + WS_LSE);
    for (int m = gw; m < M; m += NGW) {
        const int h = lane >> 2;
        const float l0 = lse[(size_t)m * 16 + h], l1 = lse[(size_t)(M + m) * 16 + h], l2 = lse[(size_t)(2 * M + m) * 16 + h];
        const float mx = fmaxf(l0, fmaxf(l1, l2));
        float w0 = __expf(l0 - mx), w1 = __expf(l1 - mx), w2 = __expf(l2 - mx);
        const float inv = 1.f / (w0 + w1 + w2); w0 *= inv; w1 *= inv; w2 *= inv;
#pragma unroll
        for (int hf = 0; hf < 2; ++hf) {
            const size_t off = (size_t)m * D + 16 * lane + 8 * hf;
            const v4u a = *(const v4u*)(WSB(WS_SCR) + off), b = *(const v4u*)(WSB(WS_SCR + SLOT) + off), c = *(const v4u*)(WSB(WS_SCR + 2 * SLOT) + off);
            v4u o;
            o.x = pk2(w0 * bflo(a.x) + w1 * bflo(b.x) + w2 * bflo(c.x), w0 * bfhi(a.x) + w1 * bfhi(b.x) + w2 * bfhi(c.x));
            o.y = pk2(w0 * bflo(a.y) + w1 * bflo(b.y) + w2 * bflo(c.y), w0 * bfhi(a.y) + w1 * bfhi(b.y) + w2 * bfhi(c.y));
            o.z = pk2(w0 * bflo(a.z) + w1 * bflo(b.z) + w2 * bflo(c.z), w0 * bfhi(a.z) + w1 * bfhi(b.z) + w2 * bfhi(c.z));
            o.w = pk2(w0 * bflo(a.w) + w1 * bflo(b.w) + w2 * bflo(c.w), w0 * bfhi(a.w) + w1 * bfhi(b.w) + w2 * bfhi(c.w));
            *(v4u*)(WSB(WS_SCR + 3 * SLOT) + off) = o;
        }
    }
}

__device__ __forceinline__ int crow(int r, int hi) { return (r & 3) + 8 * (r >> 2) + 4 * hi; }
typedef short v4i16_t __attribute__((ext_vector_type(4)));
__device__ __forceinline__ void datt_phase(Frame& F, bf16* QO, const bf16* Kg, const bf16* Vg, float* lse, const float* tabg, int dil) {
    const int tid = F.tid, lane = F.lane, w = F.wave, r32 = lane & 31, hi = lane >> 5;
    LAS unsigned char* LK = F.lds + RING_OFF; LAS unsigned char* LV = LK + 49152; LAS unsigned char* LST = LK + 98304 + w * 4096;
    LAS float* TABX = (LAS float*)(F.lds + XTRA_OFF); LAS float* WSF = TABX + 256 + w * 64;
    const int nqb = (SEQ / dil) / 256;
    const int per_bh = dil * nqb;
    for (int uid = F.vcu; uid < BATCH * 16 * 32; uid += F.G) {
        const int b = uid / (16 * per_bh), h = (uid / per_bh) % 16, rq = uid % per_bh, res = rq / nqb, qblk = rq % nqb;
        const int q0 = qblk * 256;
        const size_t rowb = (size_t)b * SEQ + res;
        v4u kreg[6], vreg[6];
#pragma unroll
        for (int p = 0; p < 6; ++p) { const int idx = p * 64 + (tid >> 3); int j = q0 - 128 + idx; j = j < 0 ? 0 : j;
            const size_t off = (rowb + (size_t)dil * j) * D + h * 64 + (tid & 7) * 8;
            kreg[p] = *(const v4u*)(Kg + off); vreg[p] = *(const v4u*)(Vg + off); }
        const size_t qrow = rowb + (size_t)dil * (q0 + 32 * w + r32);
        bf16x8 qr[4];
#pragma unroll
        for (int d0 = 0; d0 < 4; ++d0) qr[d0] = *(const bf16x8*)(QO + qrow * D + h * 64 + 16 * d0 + 8 * hi);
        __syncthreads();
#pragma unroll
        for (int p = 0; p < 6; ++p) { const int idx = p * 64 + (tid >> 3), ch = tid & 7;
            *(LAS v4u*)(LK + idx * 128 + ((ch ^ ((idx >> 1) & 7)) << 4)) = kreg[p];
            *(LAS v4u*)(LV + idx * 128 + ((ch ^ (((idx >> 1) & 1) << 2)) << 4)) = vreg[p]; }
        if (tid < 192) { const int rel = tid - 31; TABX[tid] = (rel >= 0 && rel <= 128) ? tabg[h * 129 + rel] : -1.0e30f; }
        __syncthreads();
        f32x16 p[5];
#pragma unroll
        for (int blk = 0; blk < 5; ++blk) {
            p[blk] = (f32x16){0.f, 0.f, 0.f, 0.f, 0.f, 0.f, 0.f, 0.f, 0.f, 0.f, 0.f, 0.f, 0.f, 0.f, 0.f, 0.f};
            const int krow = 32 * (w + blk) + r32;
#pragma unroll
            for (int d0 = 0; d0 < 4; ++d0) {
                const bf16x8 kf = *(const LAS bf16x8*)(LK + krow * 128 + (((2 * d0 + hi) ^ ((r32 >> 1) & 7)) << 4));
                p[blk] = __builtin_amdgcn_mfma_f32_32x32x16_bf16(kf, qr[d0], p[blk], 0, 0, 0);
            }
        }
        float mx = -3.0e38f;
        const LAS float* tb = TABX + (r32 - 4 * hi);
#pragma unroll
        for (int blk = 0; blk < 5; ++blk) {
            const bool dead = (q0 == 0) && (w + blk < 4);
#pragma unroll
            for (int r = 0; r < 16; ++r) {
                float s = p[blk][r] + tb[159 - 32 * blk - (r & 3) - 8 * (r >> 2)];
                s = dead ? -1.0e30f : s;
                p[blk][r] = s; mx = fmaxf(mx, s);
            }
        }
        mx = fmaxf(mx, __shfl_xor(mx, 32));
        float l = 0.f;
#pragma unroll
        for (int blk = 0; blk < 5; ++blk)
#pragma unroll
            for (int r = 0; r < 16; ++r) { const float e = __builtin_amdgcn_exp2f(p[blk][r] - mx); p[blk][r] = e; l += e; }
        l += __shfl_xor(l, 32);
        if (hi == 0) { WSF[r32] = 1.0f / l; lse[qrow * 16 + h] = (mx + __builtin_amdgcn_logf(l)) * LN2; }
        f32x16 o[2];
        o[0] = (f32x16){0.f, 0.f, 0.f, 0.f, 0.f, 0.f, 0.f, 0.f, 0.f, 0.f, 0.f, 0.f, 0.f, 0.f, 0.f, 0.f}; o[1] = o[0];
        const int vrow0 = 4 * hi + ((lane & 15) >> 2), ch0 = 2 * ((lane >> 4) & 1) + ((lane & 3) >> 1), hf = lane & 1;
#pragma unroll
        for (int blk = 0; blk < 5; ++blk)
#pragma unroll
            for (int s = 0; s < 2; ++s) {
                v4u pw; pw.x = pk2(p[blk][8 * s], p[blk][8 * s + 1]); pw.y = pk2(p[blk][8 * s + 2], p[blk][8 * s + 3]); pw.z = pk2(p[blk][8 * s + 4], p[blk][8 * s + 5]); pw.w = pk2(p[blk][8 * s + 6], p[blk][8 * s + 7]);
                const bf16x8 pa = __builtin_bit_cast(bf16x8, pw);
#pragma unroll
                for (int d0 = 0; d0 < 2; ++d0) {
                    const int row0 = 32 * (w + blk) + 16 * s + vrow0;
                    const int cx = ((4 * d0 + ch0) ^ (((vrow0 >> 1) & 1) << 2)) << 4;
                    const v4i16_t lo = __builtin_amdgcn_ds_read_tr16_b64_v4i16((LAS v4i16_t*)(LV + row0 * 128 + cx + hf * 8));
                    const v4i16_t hh = __builtin_amdgcn_ds_read_tr16_b64_v4i16((LAS v4i16_t*)(LV + (row0 + 8) * 128 + cx + hf * 8));
                    const bf16x8 vf = (bf16x8){lo[0], lo[1], lo[2], lo[3], hh[0], hh[1], hh[2], hh[3]};
                    o[d0] = __builtin_amdgcn_mfma_f32_32x32x16_bf16(pa, vf, o[d0], 0, 0, 0);
                }
            }
        LDS_WAIT();
        LAS bf16* stg = (LAS bf16*)LST;
#pragma unroll
        for (int r = 0; r < 16; ++r) { const int q = crow(r, hi); const float il = WSF[q];
            stg[q * 64 + r32] = (bf16)f2bf(o[0][r] * il); stg[q * 64 + 32 + r32] = (bf16)f2bf(o[1][r] * il); }
        LDS_WAIT(); asm volatile("" ::: "memory");
#pragma unroll
        for (int i = 0; i < 4; ++i) { const int row = i * 8 + (lane >> 3), ch = lane & 7;
            const v4u v = *(const LAS v4u*)(stg + row * 64 + ch * 8);
            *(v4u*)(QO + (rowb + (size_t)dil * (q0 + 32 * w + row)) * D + h * 64 + ch * 8) = v; }
    }
    __syncthreads();
}

__device__ __forceinline__ void scan_phase(Frame& F, bf16* Rb, const bf16* Kb, const bf16* Vb, const bf16* LWb, const bf16* Ab,
                                           const float* k_k, const float* k_a, const float* r_k, const float* lnx_g, const float* lnx_b) {
    if (F.vcu >= 32) return;
    const int lane = F.lane, w = F.wave, b = F.vcu >> 4, h = F.vcu & 15, col = h * 64;
    LAS float* KK = (LAS float*)(F.lds + RING_OFF); LAS float* BB = KK + 4096; LAS float* WW = KK + 8192; LAS float* KP = KK + 12288; LAS float* RR = KK + 16384; LAS float* VV = KK + 20480; LAS float* YB = KK + 24576; LAS float* BON = KK + 28672;
    const float kkc = k_k[col + lane], kac = k_a[col + lane], rkc = r_k[col + lane], gg = lnx_g[col + lane], gb = lnx_b[col + lane];
    float st[64];
#pragma unroll
    for (int k = 0; k < 64; ++k) st[k] = 0.f;
    for (int c = 0; c < SEQ / 64; ++c) {
#pragma unroll 2
        for (int tt = 0; tt < 8; ++tt) {
            const int t = 8 * w + tt; const size_t idx = ((size_t)b * SEQ + c * 64 + t) * D + col + lane;
            const float kv = bf2f(Kb[idx]), rv = bf2f(Rb[idx]), vv = bf2f(Vb[idx]), av = bf2f(Ab[idx]), lw = bf2f(LWb[idx]);
            const float kkr = kv * kkc; const float ss = wave_sum(kkr * kkr);
            const float kk = kkr / fmaxf(sqrtf(ss), 1e-12f);
            const float kp = kv * (1.f + (av - 1.f) * kac);
            const float bon = wave_sum(rv * kp * rkc);
            KK[t * 64 + lane] = kk; BB[t * 64 + lane] = kk * av; WW[t * 64 + lane] = __expf(lw); KP[t * 64 + lane] = kp; RR[t * 64 + lane] = rv; VV[t * 64 + lane] = vv;
            if (lane == 0) BON[t] = bon;
        }
        __syncthreads();
        if (w == 0) {
            for (int t = 0; t < 64; ++t) {
                const float vv = VV[t * 64 + lane];
                float sa = 0.f;
#pragma unroll
                for (int k4 = 0; k4 < 16; ++k4) { const f32x4 q = *(const LAS f32x4*)(KK + t * 64 + 4 * k4); sa += st[4 * k4] * q.x + st[4 * k4 + 1] * q.y + st[4 * k4 + 2] * q.z + st[4 * k4 + 3] * q.w; }
                sa = -sa;
                float y = 0.f;
#pragma unroll
                for (int k4 = 0; k4 < 16; ++k4) {
                    const f32x4 wq = *(const LAS f32x4*)(WW + t * 64 + 4 * k4), bq = *(const LAS f32x4*)(BB + t * 64 + 4 * k4), kq = *(const LAS f32x4*)(KP + t * 64 + 4 * k4), rq = *(const LAS f32x4*)(RR + t * 64 + 4 * k4);
                    st[4 * k4] = st[4 * k4] * wq.x + sa * bq.x + vv * kq.x; st[4 * k4 + 1] = st[4 * k4 + 1] * wq.y + sa * bq.y + vv * kq.y;
                    st[4 * k4 + 2] = st[4 * k4 + 2] * wq.z + sa * bq.z + vv * kq.z; st[4 * k4 + 3] = st[4 * k4 + 3] * wq.w + sa * bq.w + vv * kq.w;
                    y += st[4 * k4] * rq.x + st[4 * k4 + 1] * rq.y + st[4 * k4 + 2] * rq.z + st[4 * k4 + 3] * rq.w;
                }
                YB[t * 64 + lane] = y;
            }
        }
        __syncthreads();
#pragma unroll 2
        for (int tt = 0; tt < 8; ++tt) {
            const int t = 8 * w + tt; const size_t idx = ((size_t)b * SEQ + c * 64 + t) * D + col + lane;
            const float y = YB[t * 64 + lane];
            const float mean = wave_sum(y) * (1.f / 64.f); const float d = y - mean;
            const float var = wave_sum(d * d) * (1.f / 64.f);
            const float yn = d * (1.f / sqrtf(var + GN_EPS)) * gg + gb + BON[t] * VV[t * 64 + lane];
            Rb[idx] = (bf16)f2bf(yn);
        }
        __syncthreads();
    }
}
enum { T_PROA = 0, T_PROB, T_GEMM_B, T_GEMM_RESID, T_GEMM_SOFTMAX, T_CONV, T_LN, T_DATT, T_COMBINE, T_SCAN };
constexpr int NPH = 58;
#ifdef ONLY
#define ON(k) ((k) == ONLY)
#else
#define ON(k) true
#endif
struct PD {
    int type;
    const char* A; const char* B; int lda, ldb, K, N, ksplit, smode; long kjump;
    int emode; bf16* O; bf16* O2; int ldc, split_cols; long split_stride; float scale0; const float* bias; const float* p0; const float* p1;
    const float* base;
    const float* g; const float* b; int flag; int layer;
};
__device__ __forceinline__ void pd_gemm(PD& d, int type, const void* A, int lda, const void* B, int ldb, int K, int N) {
    d.type = type; d.A = (const char*)A; d.lda = lda; d.B = (const char*)B; d.ldb = ldb; d.K = K; d.N = N; d.ksplit = 1 << 30; d.kjump = 0; d.smode = 0;
    d.emode = pg8::EM_PLAIN; d.O = nullptr; d.O2 = nullptr; d.ldc = 1024; d.split_cols = 0; d.split_stride = 0; d.scale0 = 1.f; d.bias = nullptr; d.p0 = nullptr; d.p1 = nullptr; d.base = nullptr;
}
__device__ __forceinline__ void pd_tail(PD& d, const KArgs a, int l, int t) {
    unsigned char* ws = a.ws(); const size_t xq = lw_xq(l);
    bf16* s0 = WSB(WS_SCR); bf16* s1 = WSB(WS_SCR + SLOT); bf16* s2 = WSB(WS_SCR + 2 * SLOT); bf16* XB = WSB(WS_XB);
    switch (t) {
    case 0: pd_gemm(d, T_GEMM_B, XB, D, WSB(xq), D, D, D); d.O = s0; d.split_cols = 1024; d.scale0 = 0.0625f * LOG2E; break;
    case 1: pd_gemm(d, T_GEMM_SOFTMAX, s0, D, WSB(WS_KB) + (size_t)l * 524288, D, 256, D); d.smode = 1; d.O = s1; break;
    case 2: pd_gemm(d, T_GEMM_B, s1, D, WSB(WS_VT) + (size_t)l * 524288, 512, 256, D); d.smode = 2; d.O = s2; break;
    case 3: pd_gemm(d, T_GEMM_RESID, s2, D, WSB(xq + 2 * MiB), D, D, D); d.base = a.out(); break;
    case 4: d.type = T_LN; d.g = a.in(34) + (size_t)(l * 3 + 1) * D; d.b = a.in(35) + (size_t)(l * 3 + 1) * D; d.flag = 0; break;
    case 5: pd_gemm(d, T_GEMM_B, XB, D, WSB(xq + 4 * MiB), D, D, FF); d.emode = pg8::EM_RELU2; d.O = s0; d.ldc = FF; break;
    case 6: pd_gemm(d, T_GEMM_RESID, s0, FF, WSB(xq + 12 * MiB), FF, FF, D); d.base = a.out(); break;
    default: d.type = T_LN; d.g = a.in(34) + (size_t)(l * 3 + 2) * D; d.b = a.in(35) + (size_t)(l * 3 + 2) * D; d.flag = (l == 1); break;
    }
}
__device__ __forceinline__ void make_pd(PD& d, const KArgs a, int ph) {
    unsigned char* ws = a.ws();
    bf16* s0 = WSB(WS_SCR); bf16* s1 = WSB(WS_SCR + SLOT); bf16* s2 = WSB(WS_SCR + 2 * SLOT); bf16* s3 = WSB(WS_SCR + 3 * SLOT); bf16* s4 = WSB(WS_SCR + 4 * SLOT); bf16* XB = WSB(WS_XB);
    d.type = -1; d.flag = 0; d.layer = 0; d.g = nullptr; d.b = nullptr;
    if (ph == 0) { d.type = T_PROA; return; }
    if (ph == 1) { pd_gemm(d, T_GEMM_B, nullptr, D, nullptr, D, D, D); d.smode = 3; d.emode = pg8::EM_KV; return; }
    if (ph == 14) { d.type = T_PROB; return; }
    int l, t;
    if (ph < 14) { l = 0; t = ph - 2; } else if (ph < 32) { l = 1; t = ph - 15; } else if (ph < 46) { l = 2; t = ph - 32; } else { l = 3; t = ph - 46; }
    d.layer = l;
    const int kind = l % 3, j = l / 3;
    const int nhead = kind == 0 ? 4 : (kind == 1 ? 9 : 6);
    if (t >= nhead) { pd_tail(d, a, l, t - nhead); return; }
    const float* lng = a.in(34) + (size_t)(l * 3) * D; const float* lnb = a.in(35) + (size_t)(l * 3) * D;
    if (kind == 0) {
        switch (t) {
        case 0: pd_gemm(d, T_GEMM_B, XB, D, WSB(WS_WA), D, D, 2 * D); d.emode = pg8::EM_GLU; d.O = s0; d.bias = a.in(4) + (size_t)j * 2 * D; break;
        case 1: d.type = T_CONV; break;
        case 2: pd_gemm(d, T_GEMM_RESID, s1, D, WSB(WS_WA + 4 * MiB), D, D, D); d.base = (l == 0) ? a.in(0) : a.out(); d.bias = a.in(10) + (size_t)j * D; break;
        default: d.type = T_LN; d.g = lng; d.b = lnb; break;
        }
    } else if (kind == 1) {
        if (t < 6) {
            const int g = t >> 1;
            if ((t & 1) == 0) { pd_gemm(d, T_GEMM_B, XB, D, WSB(WS_WB) + (size_t)g * 3072 * D, D, D, 3072); d.O = WSB(WS_SCR + g * SLOT); d.O2 = s3; d.split_cols = 1024; d.split_stride = SLOT / 2; d.scale0 = 0.125f * LOG2E; }
            else { d.type = T_DATT; d.flag = g; }
        } else if (t == 6) d.type = T_COMBINE;
        else if (t == 7) { pd_gemm(d, T_GEMM_RESID, s3, D, WSB(WS_WB + 18 * MiB), D, D, D); d.base = a.out(); }
        else { d.type = T_LN; d.g = lng; d.b = lnb; }
    } else {
        switch (t) {
        case 0: pd_gemm(d, T_GEMM_B, XB, D, WSB(WS_WC), 2 * D, 2 * D, 3328); d.ksplit = 16; d.kjump = (long)((const char*)s4 - (const char*)XB) - 16 * 128;
                d.emode = pg8::EM_RKV; d.O = s0; d.O2 = s1; d.split_cols = 1024; d.split_stride = SLOT / 2; break;
        case 1: pd_gemm(d, T_GEMM_B, WSB(WS_L), 256, WSB(WS_WC + 13 * MiB), 256, 256, 2 * D); d.emode = pg8::EM_L2A; d.O = s4; d.O2 = s3; d.split_cols = 1024; d.split_stride = 0; d.p0 = a.in(15); d.p1 = a.in(18); break;
        case 2: d.type = T_SCAN; break;
        case 3: pd_gemm(d, T_GEMM_B, WSB(WS_L), 256, WSB(WS_WC + 13 * MiB) + (size_t)2048 * 256, 256, 256, D); d.emode = pg8::EM_L2B; d.O = s0; break;
        case 4: pd_gemm(d, T_GEMM_RESID, s0, D, WSB(WS_WC + 15 * MiB), D, D, D); d.base = a.out(); break;
        default: d.type = T_LN; d.g = lng; d.b = lnb; break;
        }
    }
}

__global__ void __launch_bounds__(NWAVES * 64, 2) fwd_kernel(Args) {
    extern __shared__ __attribute__((aligned(16))) unsigned char lds[];
    Frame F;
    F.lds = (LAS unsigned char*)lds; F.a.p = (const char CAS*)__builtin_amdgcn_kernarg_segment_ptr();
    const int wave_s = __builtin_amdgcn_readfirstlane((int)threadIdx.x >> 6);
    F.tid = threadIdx.x; F.lane = F.tid & 63; F.wave = wave_s;
    F.G = gridDim.x; { const int bx = blockIdx.x; F.vcu = (F.G % 8 == 0) ? (bx % 8) * (F.G / 8) + bx / 8 : bx; }
    unsigned char* ws = F.a.ws();
    const int ph_lo = F.a.ph_lo(), ph_hi = F.a.ph_hi();
    volatile LAS unsigned* MISC = (volatile LAS unsigned*)(F.lds + MISC_OFF);
    for (int u = F.tid; u < (XTRA_OFF - LDSCTL_OFF) / 4; u += NWAVES * 64) ((LAS unsigned*)(F.lds + LDSCTL_OFF))[u] = 0u;
    __syncthreads();
    const bool multi = (ph_hi - ph_lo) > 1;
    XcdBarrier bar; bar.bar = (unsigned*)(ws + WS_CTL) + CW_BAR; bar.x = 0; bar.st = nullptr;
    if (multi) bar = xcd_barrier_post((unsigned*)(ws + WS_CTL) + CW_BAR, MISC + 8, F.tid);

#pragma unroll 1
    for (int ph = ph_lo; ph < ph_hi; ++ph) {
        { int l_ = (int)__builtin_amdgcn_mbcnt_hi(~0u, __builtin_amdgcn_mbcnt_lo(~0u, 0u)); asm volatile("" : "+v"(l_)); F.lane = l_; F.wave = wave_s; F.tid = wave_s * 64 + l_; }
        { const char CAS* kp_ = (const char CAS*)__builtin_amdgcn_kernarg_segment_ptr(); asm volatile("" : "+s"(kp_)); F.a.p = kp_; }
        unsigned char* ws = F.a.ws();
        PD d; make_pd(d, F.a, ph);
        switch (d.type) {
        case T_PROA: if (ON(T_PROA)) pro_phase(F, 0); break;
        case T_PROB: if (ON(T_PROB)) pro_phase(F, 1); break;
        case T_GEMM_B: if (ON(T_GEMM_B)) {
            pg8::Gemm g{d.lda, d.ldb, d.K, d.ksplit, d.kjump};
            pg8::Sched S; S.nM = M / 256; S.nN = d.N / 256; S.nwg = S.nM * S.nN; S.G = F.G; S.c = (int)blockIdx.x; S.mode = d.smode; S.A = d.A; S.B = d.B; S.tA = (long)256 * d.lda * 2; S.tB = (long)256 * d.ldb * 2;
            S.memb = (const char*)(ws + WS_MEMB); S.wxkv = (const char*)(ws + WS_SCR + 4 * SLOT);
            pg8::EpiB E{d.emode, d.O, d.O2, d.ldc, d.split_cols, d.split_stride, d.scale0, d.bias, d.p0, d.p1, WSB(WS_KB), WSB(WS_VT), WSB(WS_L)};
            pg8::gemm_phase<pg8::EpiB, true>(F.lds + RING_OFF, g, S, E, F.tid);
        } break;
        case T_GEMM_RESID: if (ON(T_GEMM_RESID)) {
            pg8::Gemm g{d.lda, d.ldb, d.K, d.ksplit, d.kjump};
            pg8::Sched S; S.nM = M / 256; S.nN = d.N / 256; S.nwg = S.nM * S.nN; S.G = F.G; S.c = (int)blockIdx.x; S.mode = 0; S.A = d.A; S.B = d.B; S.tA = (long)256 * d.lda * 2; S.tB = (long)256 * d.ldb * 2; S.memb = nullptr; S.wxkv = nullptr;
            pg8::EpiResid E{d.base, F.a.out(), d.bias, ALPHA};
            pg8::gemm_phase<pg8::EpiResid, true>(F.lds + RING_OFF, g, S, E, F.tid);
        } break;
        case T_GEMM_SOFTMAX: if (ON(T_GEMM_SOFTMAX)) {
            pg8::Gemm g{d.lda, d.ldb, d.K, d.ksplit, d.kjump};
            pg8::Sched S; S.nM = M / 256; S.nN = d.N / 256; S.nwg = S.nM * S.nN; S.G = F.G; S.c = (int)blockIdx.x; S.mode = 1; S.A = d.A; S.B = d.B; S.tA = 0; S.tB = 0; S.memb = nullptr; S.wxkv = nullptr;
            pg8::EpiSoftmax E{d.O};
            pg8::gemm_phase<pg8::EpiSoftmax, false>(F.lds + RING_OFF, g, S, E, F.tid);
        } break;
        case T_CONV: if (ON(T_CONV)) { const int j = d.layer / 3;
            conv_phase(F, WSB(WS_SCR), WSB(WS_SCR + SLOT), F.a.in(5) + (size_t)j * 31 * D, F.a.in(6) + (size_t)j * D, F.a.in(7) + (size_t)j * D, F.a.in(8) + (size_t)j * D); } break;
        case T_LN: if (ON(T_LN)) ln_phase(F, d.g, d.b, d.flag); break;
        case T_DATT: if (ON(T_DATT)) { const int g = d.flag;
            datt_phase(F, WSB(WS_SCR + g * SLOT), WSB(WS_SCR + 3 * SLOT), WSB(WS_SCR + 4 * SLOT), (float*)(ws + WS_LSE) + (size_t)g * M * 16, (const float*)(ws + WS_TAB) + g * 16 * 129, g == 0 ? 1 : (g == 1 ? 4 : 16)); } break;
        case T_COMBINE: if (ON(T_COMBINE)) combine_phase(F); break;
        case T_SCAN: if (ON(T_SCAN)) scan_phase(F, WSB(WS_SCR), WSB(WS_SCR + SLOT), WSB(WS_SCR + 2 * SLOT), WSB(WS_SCR + 4 * SLOT), WSB(WS_SCR + 3 * SLOT), F.a.in(23), F.a.in(24), F.a.in(25), F.a.in(26), F.a.in(27)); break;
        default: break;
        }
        if (ph + 1 < ph_hi) xcd_barrier(bar, F.tid);
    }
}

extern "C" void kernel_launch(void* const* d_in, const int* in_sizes, int n_in, void* d_out, int out_size, void* d_ws, size_t ws_size, hipStream_t stream) {
    if (n_in != 36 || out_size != M * D || ws_size < WS_END) { fprintf(stderr, "kernel_launch: unexpected problem (n_in %d out %d ws %zu)\n", n_in, out_size, ws_size); return; }
    (void)in_sizes;
    if (hipFuncSetAttribute((const void*)fwd_kernel, hipFuncAttributeMaxDynamicSharedMemorySize, LDS_BYTES) != hipSuccess) { fprintf(stderr, "kernel_launch: hipFuncSetAttribute failed\n"); return; }
    const int grid = 256;
    (void)hipMemsetAsync((char*)d_ws + WS_CTL, 0, CTL_ZERO_BYTES, stream);
    Args a{};
    for (int i = 0; i < 36; ++i) a.in[i] = (const float*)d_in[i];
    a.out = (float*)d_out; a.ws = (unsigned char*)d_ws;
#ifndef ONE_LAUNCH
    for (int ph = 0; ph < NPH; ++ph) { a.ph_lo = ph; a.ph_hi = ph + 1; hipLaunchKernelGGL(fwd_kernel, dim3(grid), dim3(NWAVES * 64), LDS_BYTES, stream, a); }
#else
    a.ph_lo = 0; a.ph_hi = NPH; hipLaunchKernelGGL(fwd_kernel, dim3(grid), dim3(NWAVES * 64), LDS_BYTES, stream, a);
#endif
}
```

```cpp
#include <hip/hip_runtime.h>
#include <cstdio>
#include <cstdint>
#define ONE_LAUNCH 1
namespace pg8 {
#define PG8_LAS __attribute__((address_space(3)))
typedef unsigned short bf16_t;
typedef short bf16x8 __attribute__((ext_vector_type(8)));
typedef float f32x4 __attribute__((ext_vector_type(4)));
typedef unsigned u32x4 __attribute__((ext_vector_type(4)));
constexpr int BM = 256, BK = 64, HALF = 128, HTB = HALF * BK * 2  , STAGE_BYTES = 8 * HTB, NXCD = 8, WGM = 8;

__host__ __device__ __forceinline__ int lds_byte(int r, int c) { const int st = (r >> 4) * 2 + (c >> 5), rr = r & 15, cc = c & 31, ob = rr * 64 + cc * 2; return st * 1024 + (ob ^ (((ob >> 9) & 1) << 5)); }
__host__ __device__ __forceinline__ void stage_rc(int b, int& R, int& C) { const int st = b / 1024, sb = b % 1024, swz = sb ^ (((sb >> 9) & 1) << 5); R = (st >> 1) * 16 + swz / 64; C = (st & 1) * 32 + (swz % 64) / 2; }
__host__ __device__ __forceinline__ int perm32(int rho) { const int n = rho >> 4, i = rho & 15; return 8 * (i >> 2) + 4 * n + (i & 3); }

struct Unit { int pm, pn, tag; const char* a; const char* b; };
struct Gemm { int lda, ldb, K, ksplit; long kjump; };

struct Sched {
    int nM, nN, nwg, G, c, mode; const char* A; const char* B; long tA, tB; const char* memb; const char* wxkv;
    __device__ __forceinline__ bool next(int i, Unit& u) const {
        const long L = (long)i * G + c;
        if (mode == 3) {
            if (L >= 64) return false;
            const int layer = (int)L >> 4; int t = (int)L & 15;
            if (t < 8) { u.pm = t >> 2; u.pn = t & 3; u.a = memb + (long)u.pm * 524288; u.b = wxkv + (long)layer * 4194304 + (long)u.pn * 524288; u.tag = layer * 2; }
            else { t -= 8; u.pm = t >> 1; u.pn = t & 1; u.a = wxkv + (long)layer * 4194304 + (long)(4 + u.pm) * 524288; u.b = memb + (long)u.pn * 524288; u.tag = layer * 2 + 1; }
            return true;
        }
        if (L >= nwg) return false;
        int wgid = (int)L; { const int q = nwg / NXCD, r = nwg % NXCD, xcd = wgid % NXCD, off = wgid / NXCD; wgid = (xcd < r ? xcd * (q + 1) : r * (q + 1) + (xcd - r) * q) + off; }
        const int nig = WGM * nN, gid = wgid / nig, fm = gid * WGM, gsz = (nM - fm) < WGM ? (nM - fm) : WGM;
        u.pm = fm + ((wgid % nig) % gsz); u.pn = (wgid % nig) / gsz; u.tag = 0;
        if (mode == 0) { u.a = A + (long)u.pm * tA; u.b = B + (long)u.pn * tB; }
        else if (mode == 1) { u.a = A + (long)u.pm * 524288 + u.pn * 512; u.b = B + (long)(u.pm >> 5) * 524288 + u.pn * 512; }
        else { u.a = A + (long)u.pm * 524288 + u.pn * 512; u.b = B + (long)u.pn * 262144 + (u.pm >> 5) * 512; }
        return true;
    }
};

__device__ __forceinline__ unsigned cvt_pk_bf16(float lo, float hi) { unsigned r; asm volatile("v_cvt_pk_bf16_f32 %0, %1, %2" : "=v"(r) : "v"(lo), "v"(hi)); return r; }
__device__ __forceinline__ float sigm(float x) { return __builtin_amdgcn_rcpf(1.0f + __builtin_amdgcn_exp2f(-1.4426950408889634f * x)); }
__device__ __forceinline__ float tanh_f(float x) { return 1.0f - 2.0f * __builtin_amdgcn_rcpf(1.0f + __builtin_amdgcn_exp2f(2.8853900817779268f * x)); }
__device__ __forceinline__ float bflo(unsigned w) { return __uint_as_float(w << 16); }
__device__ __forceinline__ float bfhi(unsigned w) { return __uint_as_float(w & 0xffff0000u); }

enum { EM_PLAIN = 0, EM_RELU2 = 1, EM_GLU = 2, EM_RKV = 3, EM_L2A = 4, EM_KV = 5, EM_L2B = 6 };
struct EpiB {
    static constexpr bool PERM = true, AFTER_DRAIN = false;
    int mode; bf16_t* O; bf16_t* O2; int ldc; int split_cols; long split_stride; float scale0; const float* bias; const float* p0; const float* p1; bf16_t* kb; bf16_t* vt; bf16_t* Lb;
    __device__ __forceinline__ void operator()(const f32x4 (&acc)[2][2][4][2], const Unit& u, int wr, int wc, int fr, int fq) const {
        const int rowl = u.pm * BM + wr * 64 + fr, cl = wc * 32 + 8 * fq;
        if (mode == EM_GLU) {
            const int oc = u.pn * 128 + cl;
            f32x4 bv[2], bg[2];
#pragma unroll
            for (int n = 0; n < 2; ++n) { bv[n] = *(const f32x4*)(bias + oc + 4 * n); bg[n] = *(const f32x4*)(bias + 1024 + oc + 4 * n); }
#pragma unroll
            for (int ai = 0; ai < 2; ++ai)
#pragma unroll
                for (int m = 0; m < 4; ++m) {
                    float o[8];
#pragma unroll
                    for (int n = 0; n < 2; ++n)
#pragma unroll
                        for (int i = 0; i < 4; ++i) { const float v = acc[ai][0][m][n][i] + bv[n][i], g = acc[ai][1][m][n][i] + bg[n][i]; o[4 * n + i] = v * sigm(g); }
                    u32x4 w; w.x = cvt_pk_bf16(o[0], o[1]); w.y = cvt_pk_bf16(o[2], o[3]); w.z = cvt_pk_bf16(o[4], o[5]); w.w = cvt_pk_bf16(o[6], o[7]);
                    *(u32x4*)(O + (size_t)(rowl + ai * HALF + m * 16) * 1024 + oc) = w;
                }
            return;
        }
        bf16_t* base = O; int ld = ldc; int colt = u.pn * BM; float sc = 1.f; int tsel = 0;
        if (mode == EM_KV) { const int layer = u.tag >> 1; if (u.tag & 1) { base = vt + (size_t)layer * 524288; ld = 512; } else { base = kb + (size_t)layer * 524288; ld = 1024; } }
        else if (split_cols) { tsel = colt / split_cols; colt -= tsel * split_cols; if (tsel == 0) sc = scale0; else base = O2 + (size_t)(tsel - 1) * split_stride; }
        const bool lora = (mode == EM_RKV) && (u.pn == 12);
        if (lora) { base = Lb; ld = 256; colt = 0; sc = 1.f; }
#pragma unroll
        for (int ai = 0; ai < 2; ++ai)
#pragma unroll
            for (int m = 0; m < 4; ++m) {
                bf16_t* rowp = base + (size_t)(rowl + ai * HALF + m * 16) * ld + colt + cl;
#pragma unroll
                for (int bj = 0; bj < 2; ++bj) {
                    float o[8];
#pragma unroll
                    for (int n = 0; n < 2; ++n)
#pragma unroll
                        for (int i = 0; i < 4; ++i) o[4 * n + i] = acc[ai][bj][m][n][i] * sc;
                    if (mode == EM_RELU2) {
#pragma unroll
                        for (int i = 0; i < 8; ++i) { const float r = fmaxf(o[i], 0.f); o[i] = r * r; }
                    } else if (lora) {
                        const int c = bj * HALF + cl;
                        if (c < 64) {
#pragma unroll
                            for (int i = 0; i < 8; ++i) o[i] = tanh_f(o[i]);
                        } else if (c >= 128) {
#pragma unroll
                            for (int i = 0; i < 8; ++i) o[i] = sigm(o[i]);
                        }
                    } else if (mode == EM_L2A) {
                        const int gc = colt + bj * HALF + cl;
                        const float* pp = (tsel == 0 ? p0 : p1) + gc;
                        const f32x4 q0 = *(const f32x4*)pp, q1 = *(const f32x4*)(pp + 4);
                        const float mul = (tsel == 0) ? -0.6065306597126334f : 1.0f;
#pragma unroll
                        for (int i = 0; i < 4; ++i) { o[i] = mul * sigm(o[i] + q0[i]); o[4 + i] = mul * sigm(o[4 + i] + q1[i]); }
                    } else if (mode == EM_L2B) {
                        const u32x4 y = *(const u32x4*)(rowp + bj * HALF);
                        o[0] *= bflo(y.x); o[1] *= bfhi(y.x); o[2] *= bflo(y.y); o[3] *= bfhi(y.y); o[4] *= bflo(y.z); o[5] *= bfhi(y.z); o[6] *= bflo(y.w); o[7] *= bfhi(y.w);
                    }
                    u32x4 w; w.x = cvt_pk_bf16(o[0], o[1]); w.y = cvt_pk_bf16(o[2], o[3]); w.z = cvt_pk_bf16(o[4], o[5]); w.w = cvt_pk_bf16(o[6], o[7]);
                    *(u32x4*)(rowp + bj * HALF) = w;
                }
            }
    }
};
struct EpiResid {
    static constexpr bool PERM = false, AFTER_DRAIN = false;
    const float* base; float* out; const float* bias; float alpha;
    __device__ __forceinline__ void operator()(const f32x4 (&acc)[2][2][4][2], const Unit& u, int wr, int wc, int fr, int fq) const {
        const int col0 = u.pn * BM + wc * 32 + 4 * fq;
        f32x4 bv[2][2];
#pragma unroll
        for (int bj = 0; bj < 2; ++bj)
#pragma unroll
            for (int n = 0; n < 2; ++n) bv[bj][n] = bias ? *(const f32x4*)(bias + col0 + bj * HALF + n * 16) : (f32x4){0.f, 0.f, 0.f, 0.f};
#pragma unroll
        for (int ai = 0; ai < 2; ++ai)
#pragma unroll
            for (int m = 0; m < 4; ++m) {
                const size_t off = (size_t)(u.pm * BM + ai * HALF + wr * 64 + m * 16 + fr) * 1024 + col0;
#pragma unroll
                for (int bj = 0; bj < 2; ++bj)
#pragma unroll
                    for (int n = 0; n < 2; ++n) { const f32x4 bs = *(const f32x4*)(base + off + bj * HALF + n * 16); *(f32x4*)(out + off + bj * HALF + n * 16) = bs * alpha + acc[ai][bj][m][n] + bv[bj][n]; }
                if (m & 1) asm volatile("" ::: "memory");
            }
    }
};
struct EpiSoftmax {
    static constexpr bool PERM = true, AFTER_DRAIN = true;
    bf16_t* P;
    __device__ __forceinline__ void fused(f32x4 (&acc)[2][2][4][2], const Unit& u, int wr, int wc, int fr, int fq, PG8_LAS unsigned char* lds, int wid, int lane) const {
        PG8_LAS float* Pm = (PG8_LAS float*)lds; PG8_LAS float* Ps = Pm + 1024;
#pragma unroll
        for (int ai = 0; ai < 2; ++ai)
#pragma unroll
            for (int m = 0; m < 4; ++m) {
                float mx = -3.0e38f;
#pragma unroll
                for (int bj = 0; bj < 2; ++bj)
#pragma unroll
                    for (int n = 0; n < 2; ++n) { const f32x4 x = acc[ai][bj][m][n]; mx = fmaxf(mx, fmaxf(fmaxf(x[0], x[1]), fmaxf(x[2], x[3]))); }
                mx = fmaxf(mx, __shfl_xor(mx, 16)); mx = fmaxf(mx, __shfl_xor(mx, 32));
                if (fq == 0) Pm[(ai * HALF + wr * 64 + m * 16 + fr) * 4 + wc] = mx;
            }
        asm volatile("s_waitcnt lgkmcnt(0)" ::: "memory"); __builtin_amdgcn_s_barrier(); asm volatile("" ::: "memory");
#pragma unroll
        for (int ai = 0; ai < 2; ++ai)
#pragma unroll
            for (int m = 0; m < 4; ++m) {
                const int rl = ai * HALF + wr * 64 + m * 16 + fr;
                const f32x4 mm = *(const PG8_LAS f32x4*)(Pm + rl * 4);
                const float rm = fmaxf(fmaxf(mm[0], mm[1]), fmaxf(mm[2], mm[3]));
                float s = 0.f;
#pragma unroll
                for (int bj = 0; bj < 2; ++bj)
#pragma unroll
                    for (int n = 0; n < 2; ++n)
#pragma unroll
                        for (int i = 0; i < 4; ++i) { const float e = __builtin_amdgcn_exp2f(acc[ai][bj][m][n][i] - rm); acc[ai][bj][m][n][i] = e; s += e; }
                s += __shfl_xor(s, 16); s += __shfl_xor(s, 32);
                if (fq == 0) Ps[rl * 4 + wc] = s;
            }
        asm volatile("s_waitcnt lgkmcnt(0)" ::: "memory"); __builtin_amdgcn_s_barrier(); asm volatile("" ::: "memory");
#pragma unroll
        for (int ai = 0; ai < 2; ++ai)
#pragma unroll
            for (int m = 0; m < 4; ++m) {
                const int rl = ai * HALF + wr * 64 + m * 16 + fr;
                const f32x4 ss = *(const PG8_LAS f32x4*)(Ps + rl * 4);
                const float inv = 1.0f / ((ss[0] + ss[1]) + (ss[2] + ss[3]));
                bf16_t* rowp = P + (size_t)(u.pm * BM + rl) * 1024 + u.pn * BM + wc * 32 + 8 * fq;
#pragma unroll
                for (int bj = 0; bj < 2; ++bj) {
                    const f32x4 v0 = acc[ai][bj][m][0] * inv, v1 = acc[ai][bj][m][1] * inv;
                    u32x4 w; w.x = cvt_pk_bf16(v0[0], v0[1]); w.y = cvt_pk_bf16(v0[2], v0[3]); w.z = cvt_pk_bf16(v1[0], v1[1]); w.w = cvt_pk_bf16(v1[2], v1[3]);
                    *(u32x4*)(rowp + bj * HALF) = w;
                }
            }
    }
};

template <class Epi, bool ALIGN_EPI>
__device__ __forceinline__ void gemm_phase(PG8_LAS unsigned char* lds, const Gemm g, const Sched& S, const Epi& E, const int tid) {
    const int wid = __builtin_amdgcn_readfirstlane(tid >> 6), lane = tid & 63, wr = wid >> 2, wc = wid & 3, fr = lane & 15, fq = lane >> 4;
    const int K = g.K, nt = K / BK;
    unsigned voffA[2], voffB[2];
#pragma unroll
    for (int i = 0; i < 2; ++i) { int R, C; stage_rc(tid * 16 + i * 8192, R, C); const int Rb = Epi::PERM ? ((R & ~31) + perm32(R & 31)) : R;
        voffA[i] = (unsigned)(R * g.lda + C) * 2u; voffB[i] = (unsigned)(Rb * g.ldb + C) * 2u; }
    const size_t kstep = (size_t)(BK * 2);
    const size_t hA = (size_t)HALF * g.lda * 2, hB = (size_t)HALF * g.ldb * 2;
    const unsigned ldsw = (unsigned)wid * 1024u;
    const int aoff = lds_byte(wr * 64 + fr, fq * 8), boff = lds_byte(wc * 32 + fr, fq * 8);
    const int ksplit = g.ksplit; const long kjump = g.kjump;
#define PG8_KA(base, t) ((base) + (size_t)(t) * kstep + ((t) >= ksplit ? kjump : 0l))
#define PG8_SA(b, h) (((b) * 2 + (h)) * HTB)
#define PG8_SB(b, h) ((4 + (b) * 2 + (h)) * HTB)
#define PG8_STAGE(bufoff, gbase, voff) do { _Pragma("unroll") for (int _i = 0; _i < 2; ++_i) \
        __builtin_amdgcn_global_load_lds((const unsigned*)((const char*)(gbase) + (voff)[_i]), (PG8_LAS unsigned*)(lds + (bufoff) + ldsw + _i * 8192), 16, 0, 0); } while (0)
#define PG8_LDA(dst, b, h) do { _Pragma("unroll") for (int m = 0; m < 4; ++m) _Pragma("unroll") for (int k = 0; k < 2; ++k) dst[m][k] = *(const PG8_LAS bf16x8*)(lds + PG8_SA(b, h) + aoff + m * 2048 + k * 1024); } while (0)
#define PG8_LDB(dst, b, h) do { _Pragma("unroll") for (int n = 0; n < 2; ++n) _Pragma("unroll") for (int k = 0; k < 2; ++k) dst[n][k] = *(const PG8_LAS bf16x8*)(lds + PG8_SB(b, h) + boff + n * 2048 + k * 1024); } while (0)
#define PG8_MMA(ai, bj, At, Bt) do { __builtin_amdgcn_s_setprio(1); _Pragma("unroll") for (int m = 0; m < 4; ++m) _Pragma("unroll") for (int n = 0; n < 2; ++n) _Pragma("unroll") for (int k = 0; k < 2; ++k) \
        acc[ai][bj][m][n] = __builtin_amdgcn_mfma_f32_16x16x32_bf16(Bt[n][k], At[m][k], acc[ai][bj][m][n], 0, 0, 0); __builtin_amdgcn_s_setprio(0); } while (0)
#define PG8_WAIT_V(n) asm volatile("s_waitcnt vmcnt(" #n ")" ::: "memory")
#define PG8_WAIT_L(n) asm volatile("s_waitcnt lgkmcnt(" #n ")" ::: "memory")
#define PG8_BAR __builtin_amdgcn_s_barrier()
#define PG8_SCHED __builtin_amdgcn_sched_barrier(0)
    Unit cur, nxt; int ui = 0;
    if (!S.next(0, cur)) return;
    f32x4 acc[2][2][4][2];
#pragma unroll
    for (int a = 0; a < 2; ++a)
#pragma unroll
        for (int b = 0; b < 2; ++b)
#pragma unroll
            for (int m = 0; m < 4; ++m)
#pragma unroll
                for (int n = 0; n < 2; ++n) acc[a][b][m][n] = (f32x4){0.f, 0.f, 0.f, 0.f};
    bf16x8 At[4][2], B0[2][2], B1[2][2];
    const char* cA = cur.a; const char* cB = cur.b;
    PG8_STAGE(PG8_SB(0, 0), cB, voffB); PG8_STAGE(PG8_SB(0, 1), cB + hB, voffB); PG8_STAGE(PG8_SA(0, 0), cA, voffA); PG8_STAGE(PG8_SA(0, 1), cA + hA, voffA);
    if (wr == 1) PG8_BAR;
    PG8_WAIT_V(2); PG8_BAR;
    PG8_STAGE(PG8_SB(1, 0), cB + kstep, voffB); PG8_STAGE(PG8_SA(1, 0), PG8_KA(cA, 1), voffA); PG8_STAGE(PG8_SB(1, 1), cB + hB + kstep, voffB);
    PG8_WAIT_V(6); PG8_BAR;
    for (;;) {
        const bool has_next = S.next(ui + 1, nxt);
        const char* nA = has_next ? nxt.a : cA; const char* nB = has_next ? nxt.b : cB;
        for (int t = 0; t < nt; t += 2) {
            const bool last = (t == nt - 2);
            const char* a1 = PG8_KA(cA, t + 1);
            const char* a2 = last ? nA : PG8_KA(cA, t + 2); const char* b2 = last ? nB : cB + (size_t)(t + 2) * kstep;
            const char* a3 = last ? nA + kstep : PG8_KA(cA, t + 3); const char* b3 = b2 + kstep;
            PG8_LDB(B0, 0, 0); PG8_LDB(B1, 0, 1); PG8_SCHED; PG8_LDA(At, 0, 0); PG8_STAGE(PG8_SA(1, 1), a1 + hA, voffA);
            PG8_WAIT_V(8); PG8_WAIT_L(0); PG8_BAR; PG8_MMA(0, 0, At, B0); PG8_MMA(0, 1, At, B1); PG8_BAR; PG8_SCHED;
            PG8_LDA(At, 0, 1); PG8_STAGE(PG8_SB(0, 0), b2, voffB); PG8_STAGE(PG8_SB(0, 1), b2 + hB, voffB); PG8_STAGE(PG8_SA(0, 0), a2, voffA);
            PG8_WAIT_V(8); PG8_WAIT_L(0); PG8_BAR; PG8_MMA(1, 0, At, B0); PG8_MMA(1, 1, At, B1); PG8_BAR; PG8_SCHED;
            PG8_LDB(B0, 1, 0); PG8_LDB(B1, 1, 1); PG8_SCHED; PG8_LDA(At, 1, 0); PG8_STAGE(PG8_SA(0, 1), a2 + hA, voffA);
            PG8_WAIT_V(8); PG8_WAIT_L(0); PG8_BAR; PG8_MMA(0, 0, At, B0); PG8_MMA(0, 1, At, B1); PG8_BAR; PG8_SCHED;
            PG8_LDA(At, 1, 1); PG8_STAGE(PG8_SB(1, 0), b3, voffB); PG8_STAGE(PG8_SB(1, 1), b3 + hB, voffB); PG8_STAGE(PG8_SA(1, 0), a3, voffA);
            PG8_WAIT_V(8); PG8_WAIT_L(0); PG8_BAR; PG8_MMA(1, 0, At, B0); PG8_MMA(1, 1, At, B1); PG8_BAR; PG8_SCHED;
        }
        if constexpr (ALIGN_EPI) { if (wr == 0) PG8_BAR; }
        if constexpr (!Epi::AFTER_DRAIN) { E(acc, cur, wr, wc, fr, fq); }
        if (!has_next) break;
#pragma unroll
        for (int a = 0; a < 2; ++a)
#pragma unroll
            for (int b = 0; b < 2; ++b)
#pragma unroll
                for (int m = 0; m < 4; ++m)
#pragma unroll
                    for (int n = 0; n < 2; ++n) acc[a][b][m][n] = (f32x4){0.f, 0.f, 0.f, 0.f};
        cur = nxt; cA = nA; cB = nB; ++ui;
        if constexpr (ALIGN_EPI) { if (wr == 1) PG8_BAR; }
    }
    PG8_WAIT_V(0);
    if constexpr (!ALIGN_EPI) { if (wr == 0) PG8_BAR; }
    PG8_BAR;
    if constexpr (Epi::AFTER_DRAIN) { E.fused(acc, cur, wr, wc, fr, fq, lds, wid, lane); }
#undef PG8_KA
#undef PG8_SA
#undef PG8_SB
#undef PG8_STAGE
#undef PG8_LDA
#undef PG8_LDB
#undef PG8_MMA
#undef PG8_WAIT_V
#undef PG8_WAIT_L
#undef PG8_BAR
#undef PG8_SCHED
}
}
constexpr int NWAVES = 8;
constexpr int BATCH = 2, SEQ = 8192, D = 1024, M = BATCH * SEQ, FF = 4096, DEPTH = 4;
constexpr float ALPHA = 1.6817928305074290f;
constexpr float LN_EPS = 1e-5f, GN_EPS = 64e-5f;
constexpr float LOG2E = 1.4426950408889634f, LN2 = 0.6931471805599453f;

constexpr size_t MiB = 1u << 20;
constexpr size_t WS_CTL = 0, CTL_ZERO_BYTES = 1 * MiB;
constexpr size_t WS_TAB = 1 * MiB;
constexpr size_t WS_LSE = 2 * MiB;
constexpr size_t WS_MEMB = 5 * MiB;
constexpr size_t WS_KB = 6 * MiB;
constexpr size_t WS_VT = 10 * MiB;
constexpr size_t WS_L = 14 * MiB;
constexpr size_t WS_XB = 22 * MiB;
constexpr size_t WS_WA = 54 * MiB;
constexpr size_t WS_WB = 80 * MiB;
constexpr size_t WS_WC = 120 * MiB;
constexpr size_t WS_SCR = 157 * MiB;
constexpr size_t SLOT = 32 * MiB;
constexpr size_t WS_END = 317 * MiB;
constexpr int CW_TMO = 0, CW_CODE = 1, CW_BAR = 4096;

constexpr int RING_OFF = 0, RING_BYTES = 131072;
constexpr int LDSCTL_OFF = RING_BYTES, MISC_OFF = LDSCTL_OFF + 320, XTRA_OFF = RING_BYTES + 1024;
constexpr int LDS_BYTES = 147456;

#define GAS __attribute__((address_space(1)))
#define LAS __attribute__((address_space(3)))
typedef unsigned short bf16;
typedef unsigned v4u __attribute__((ext_vector_type(4)));
typedef unsigned v2u __attribute__((ext_vector_type(2)));
typedef float f32x4 __attribute__((ext_vector_type(4)));
typedef float f32x2 __attribute__((ext_vector_type(2)));
typedef float f32x16 __attribute__((ext_vector_type(16)));
typedef short bf16x8 __attribute__((ext_vector_type(8)));
typedef short s16x4 __attribute__((ext_vector_type(4)));
typedef GAS unsigned gu32;
#define RLX_AGENT __ATOMIC_RELAXED, __HIP_MEMORY_SCOPE_AGENT
#define LDS_WAIT() asm volatile("s_waitcnt lgkmcnt(0)" ::: "memory")
#define VM_WAIT() asm volatile("s_waitcnt vmcnt(0)" ::: "memory")
__device__ __forceinline__ unsigned f2bf(float f) { unsigned u = __builtin_bit_cast(unsigned, f); return (u + 0x7fffu + ((u >> 16) & 1u)) >> 16; }
__device__ __forceinline__ unsigned pk2(float lo, float hi) { return f2bf(lo) | (f2bf(hi) << 16); }
__device__ __forceinline__ float bf2f(unsigned short b) { return __uint_as_float((unsigned)b << 16); }
__device__ __forceinline__ float bflo(unsigned w) { return __uint_as_float(w << 16); }
__device__ __forceinline__ float bfhi(unsigned w) { return __uint_as_float(w & 0xffff0000u); }
__device__ __forceinline__ float wave_sum(float v) {
#pragma unroll
    for (int o = 1; o < 64; o <<= 1) v += __shfl_xor(v, o);
    return v;
}
__device__ __forceinline__ float sigm(float x) { return __builtin_amdgcn_rcpf(1.0f + __builtin_amdgcn_exp2f(-LOG2E * x)); }

#define XB_TMO      128
#define XB_XCNT(j)  (256  + 64 * (j))
#define XB_XSUB(j)  (1280 + 64 * (j))
#define XB_XGEN(j)  (2304 + 64 * (j))
#define XB_TOP      3328
#define XB_TOPGEN   3392
#define XCD_BAR_WORDS 3456
#define XB_SPIN_CAP (1u << 18)
__device__ __forceinline__ unsigned xb_ld(unsigned* p)              { return __hip_atomic_load(p, __ATOMIC_RELAXED, __HIP_MEMORY_SCOPE_AGENT); }
__device__ __forceinline__ unsigned xb_add(unsigned* p, unsigned v) { return __hip_atomic_fetch_add(p, v, __ATOMIC_RELAXED, __HIP_MEMORY_SCOPE_AGENT); }
__device__ __forceinline__ unsigned xb_xcc_id() { return (unsigned)__builtin_amdgcn_s_getreg((3 << 11) | 20) & 0xFu; }
#define XB_SPIN(cond, bar) do { unsigned _sp = 0; while (cond) { __builtin_amdgcn_s_sleep(1); \
    if ((++_sp & 255u) == 0u) { if (xb_ld(&(bar)[XB_TMO])) break; if (_sp > XB_SPIN_CAP) { atomicAdd(&(bar)[XB_TMO], 1u); break; } } } } while (0)
struct XcdBarrier { unsigned* bar; unsigned x; volatile LAS unsigned* st; };
__device__ __forceinline__ XcdBarrier xcd_barrier_post(unsigned* bar, volatile LAS unsigned* st, int tid) {
    XcdBarrier b; b.bar = bar; b.x = xb_xcc_id(); b.st = st;
    if (tid == 0) (void)xb_add(&bar[XB_XCNT(b.x)], 1u);
    return b;
}
__device__ __forceinline__ void xcd_barrier_complete(unsigned* bar, unsigned x, unsigned& nloc, unsigned& nx) {
    const unsigned G = gridDim.x * gridDim.y * gridDim.z;
    unsigned sum, cnt, mine, sp = 0u;
    for (;;) {
        sum = 0u; cnt = 0u; mine = 0u;
#pragma unroll
        for (unsigned j = 0; j < 16; ++j) { const unsigned c = xb_ld(&bar[XB_XCNT(j)]); sum += c; cnt += (c > 0u) ? 1u : 0u; mine = (j == x) ? c : mine; }
        if (sum == G) break;
        __builtin_amdgcn_s_sleep(1);
        if ((++sp & 255u) == 0u) { if (xb_ld(&bar[XB_TMO])) break; if (sp > XB_SPIN_CAP) { atomicAdd(&bar[XB_TMO], 1u); break; } }
    }
    nloc = mine > 0u ? mine : 1u; nx = cnt > 0u ? cnt : 1u;
}
__device__ __forceinline__ void xcd_barrier(const XcdBarrier& b, int tid) {
    asm volatile("s_waitcnt vmcnt(0)" ::: "memory");
    __syncthreads();
    if (tid == 0) {
        unsigned* bar = b.bar;
        __builtin_amdgcn_s_waitcnt(0);
        unsigned nloc = b.st[0], nx = b.st[1];
        if (nloc == 0u) { xcd_barrier_complete(bar, b.x, nloc, nx); b.st[0] = nloc; b.st[1] = nx; }
        const unsigned old = xb_add(&bar[XB_XSUB(b.x)], 1u);
        const unsigned gen = old / nloc;
        if (old + 1u == (gen + 1u) * nloc) {
            __builtin_amdgcn_fence(__ATOMIC_RELEASE, "agent");
            asm volatile("s_waitcnt vmcnt(0)" ::: "memory");
            const unsigned og = xb_add(&bar[XB_TOP], 1u);
            const unsigned tg = og / nx;
            if (og + 1u == (tg + 1u) * nx) xb_add(&bar[XB_TOPGEN], 1u);
            else XB_SPIN(xb_ld(&bar[XB_TOPGEN]) == tg, bar);
            __builtin_amdgcn_fence(__ATOMIC_ACQUIRE, "agent");
            xb_add(&bar[XB_XGEN(b.x)], 1u);
            asm volatile("s_waitcnt vmcnt(0)" ::: "memory");
        } else {
            XB_SPIN(xb_ld(&bar[XB_XGEN(b.x)]) == gen, bar);
            __builtin_amdgcn_fence(__ATOMIC_ACQUIRE, "agent");
            asm volatile("s_waitcnt vmcnt(0)" ::: "memory");
        }
    }
    __syncthreads();
}

struct Args { const float* in[36]; float* out; unsigned char* ws; int ph_lo, ph_hi; };

#define CAS __attribute__((address_space(4)))
struct KArgs {
    const char CAS* p;
    __device__ __forceinline__ const float* in(int i) const { return *(const float* const CAS*)(p + 8 * i); }
    __device__ __forceinline__ float* out() const { return *(float* const CAS*)(p + 288); }
    __device__ __forceinline__ unsigned char* ws() const { return *(unsigned char* const CAS*)(p + 296); }
    __device__ __forceinline__ int ph_lo() const { return *(const int CAS*)(p + 304); }
    __device__ __forceinline__ int ph_hi() const { return *(const int CAS*)(p + 308); }
};
struct Frame {
    LAS unsigned char* lds;
    int tid, lane, wave, vcu, G;
    KArgs a;
};
__device__ __forceinline__ void tr_item(const float* W, int ldw, int k0, int n0, bf16* WT, int ldt, int drow0, int kd0, LAS float* scr, int lane, const float* mu) {
#pragma unroll 8
    for (int i = 0; i < 32; ++i) { const int kk = 2 * i + (lane >> 5); scr[kk * 33 + (lane & 31)] = W[(size_t)(k0 + kk) * ldw + n0 + (lane & 31)]; }
    LDS_WAIT(); asm volatile("" ::: "memory");
    const int c = lane & 7;
    float m8[8];
    if (mu) {
#pragma unroll
        for (int i = 0; i < 8; ++i) m8[i] = mu[k0 + 8 * c + i];
    }
#pragma unroll
    for (int j = 0; j < 4; ++j) { const int n = (lane >> 3) + 8 * j; const LAS float* s = scr + (8 * c) * 33 + n;
        float v[8];
#pragma unroll
        for (int i = 0; i < 8; ++i) v[i] = s[i * 33];
        bf16* dst = WT + (size_t)(drow0 + n) * ldt + kd0 + 8 * c;
        if (mu) {
            v4u o, p;
            o.x = pk2(v[0] * (1.f - m8[0]), v[1] * (1.f - m8[1])); o.y = pk2(v[2] * (1.f - m8[2]), v[3] * (1.f - m8[3])); o.z = pk2(v[4] * (1.f - m8[4]), v[5] * (1.f - m8[5])); o.w = pk2(v[6] * (1.f - m8[6]), v[7] * (1.f - m8[7]));
            p.x = pk2(v[0] * m8[0], v[1] * m8[1]); p.y = pk2(v[2] * m8[2], v[3] * m8[3]); p.z = pk2(v[4] * m8[4], v[5] * m8[5]); p.w = pk2(v[6] * m8[6], v[7] * m8[7]);
            *(GAS v4u*)dst = o; *(GAS v4u*)(dst + 1024) = p;
        } else {
            v4u o; o.x = pk2(v[0], v[1]); o.y = pk2(v[2], v[3]); o.z = pk2(v[4], v[5]); o.w = pk2(v[6], v[7]);
            *(GAS v4u*)dst = o;
        }
    }
    LDS_WAIT(); asm volatile("" ::: "memory");
}
__device__ __forceinline__ void zero_item(bf16* WT, int ldt, int drow0, int kd0, int lane) {
    const int c = lane & 7;
#pragma unroll
    for (int j = 0; j < 4; ++j) { const int n = (lane >> 3) + 8 * j; *(GAS v4u*)(WT + (size_t)(drow0 + n) * ldt + kd0 + 8 * c) = (v4u){0u, 0u, 0u, 0u}; }
}
__device__ __forceinline__ void cvt_row(const float* xrow, bf16* orow, int lane) {
    const GAS f32x4* xr = (const GAS f32x4*)xrow + lane; GAS unsigned long long* o8 = (GAS unsigned long long*)orow + lane;
#pragma unroll
    for (int j = 0; j < 4; ++j) { const f32x4 v = xr[64 * j]; o8[64 * j] = (unsigned long long)pk2(v.x, v.y) | ((unsigned long long)pk2(v.z, v.w) << 32); }
}
struct TJob { const float* W; int ldw, N; bf16* WT; int ldt, drow_off, rowmode; const float* mu; };
__device__ __forceinline__ void run_job(const TJob& J, int r, LAS float* scr, int lane) {
    const int nblk = J.N / 32, kb = r / nblk, nb = r % nblk, n0 = 32 * nb;
    int drow0 = n0;
    if (J.rowmode == 1) { const int g = n0 >= 1024, nn = n0 - g * 1024; drow0 = (nn >> 7) * 256 + g * 128 + (nn & 127); }
    tr_item(J.W, J.ldw, 64 * kb, n0, J.WT, J.ldt, J.drow_off + drow0, 64 * kb, scr, lane, J.mu);
}
#define WSB(off) ((bf16*)(ws + (off)))
__device__ __forceinline__ size_t lw_base(int l) { return l == 1 ? WS_WB : (l == 2 ? WS_WC : WS_WA); }
__device__ __forceinline__ size_t lw_xq(int l) { return lw_base(l) + (l == 1 ? 20 : (l == 2 ? 17 : 6)) * MiB; }

__device__ __forceinline__ bool tail_jobs(const KArgs A, unsigned char* ws, int l, int& r, TJob& J) {
    const size_t xq = lw_xq(l);
    if (r < 512) { J = TJob{A.in(29) + (size_t)l * D * D, D, D, WSB(xq), D, 0, 0, nullptr}; return true; } r -= 512;
    if (r < 512) { J = TJob{A.in(31) + (size_t)l * D * D, D, D, WSB(xq + 2 * MiB), D, 0, 0, nullptr}; return true; } r -= 512;
    if (r < 2048) { J = TJob{A.in(32) + (size_t)l * D * FF, FF, FF, WSB(xq + 4 * MiB), D, 0, 0, nullptr}; return true; } r -= 2048;
    if (r < 2048) { J = TJob{A.in(33) + (size_t)l * FF * D, D, D, WSB(xq + 12 * MiB), FF, 0, 0, nullptr}; return true; } r -= 2048;
    return false;
}
__device__ __forceinline__ bool conv_jobs(const KArgs A, unsigned char* ws, int j, int& r, TJob& J) {
    if (r < 1024) { J = TJob{A.in(3) + (size_t)j * D * 2 * D, 2 * D, 2 * D, WSB(WS_WA), D, 0, 1, nullptr}; return true; } r -= 1024;
    if (r < 512) { J = TJob{A.in(9) + (size_t)j * D * D, D, D, WSB(WS_WA + 4 * MiB), D, 0, 0, nullptr}; return true; } r -= 512;
    return false;
}
constexpr int PROA_ITEMS = (1536 + 5120) + (4608 + 512 + 5120) + (1536 + 32 + 32 + 64 + 384 + 512 + 5120) + 4 * 1024;
constexpr int PROB_ITEMS = 1536 + 5120;
__device__ __forceinline__ void pro_phase(Frame& F, int which) {
    const KArgs A = F.a; unsigned char* ws = A.ws();
    LAS float* scr = (LAS float*)(F.lds + RING_OFF + F.wave * 16384);
    const int gw = F.vcu * NWAVES + F.wave, NGW = F.G * NWAVES, lane = F.lane;
    const int nitems = which == 0 ? PROA_ITEMS : PROB_ITEMS;
    for (int it = gw; it < nitems; it += NGW) {
        int r = it; TJob J;
        if (which == 1) {
            if (!conv_jobs(A, ws, 1, r, J)) tail_jobs(A, ws, 3, r, J);
            run_job(J, r, scr, lane); continue;
        }
        if (conv_jobs(A, ws, 0, r, J) || tail_jobs(A, ws, 0, r, J)) { run_job(J, r, scr, lane); continue; }
        if (r < 4608) { J = TJob{A.in(11), 9216, 9216, WSB(WS_WB), D, 0, 0, nullptr}; run_job(J, r, scr, lane); continue; } r -= 4608;
        if (r < 512) { J = TJob{A.in(12), D, D, WSB(WS_WB + 18 * MiB), D, 0, 0, nullptr}; run_job(J, r, scr, lane); continue; } r -= 512;
        if (tail_jobs(A, ws, 1, r, J)) { run_job(J, r, scr, lane); continue; }
        if (r < 1536) { const int s = r / 512; J = TJob{A.in(14) + (size_t)s * D * D, D, D, WSB(WS_WC), 2 * D, s * 1024, 0, A.in(13) + s * D}; run_job(J, r % 512, scr, lane); continue; } r -= 1536;
        if (r < 32) { J = TJob{A.in(16), 64, 64, WSB(WS_WC), 2 * D, 3072, 0, A.in(13) + 3 * D}; run_job(J, r, scr, lane); continue; } r -= 32;
        if (r < 32) { J = TJob{A.in(19), 64, 64, WSB(WS_WC), 2 * D, 3136, 0, A.in(13) + 4 * D}; run_job(J, r, scr, lane); continue; } r -= 32;
        if (r < 64) { J = TJob{A.in(21), 128, 128, WSB(WS_WC), 2 * D, 3200, 0, A.in(13) + 5 * D}; run_job(J, r, scr, lane); continue; } r -= 64;
        if (r < 384) {
            const int kb = r / 96, nb = r % 96, n0 = 32 * nb, mat = n0 >> 10;
            bf16* WT = WSB(WS_WC + 13 * MiB);
            const bool inband = (mat == 0 && kb == 0) || (mat == 1 && kb == 1) || (mat == 2 && kb >= 2);
            if (inband) { const float* src = mat == 0 ? A.in(17) : (mat == 1 ? A.in(20) : A.in(22)); const int ks = mat == 2 ? 64 * (kb - 2) : 0;
                tr_item(src, D, ks, n0 & 1023, WT, 256, n0, 64 * kb, scr, lane, nullptr); }
            else zero_item(WT, 256, n0, 64 * kb, lane);
            continue; } r -= 384;
        if (r < 512) { J = TJob{A.in(28), D, D, WSB(WS_WC + 15 * MiB), D, 0, 0, nullptr}; run_job(J, r, scr, lane); continue; } r -= 512;
        if (tail_jobs(A, ws, 2, r, J)) { run_job(J, r, scr, lane); continue; }
        { const int l = r / 1024; J = TJob{A.in(30) + (size_t)l * D * 2 * D, 2 * D, 2 * D, WSB(WS_SCR + 4 * SLOT + (size_t)l * 4 * MiB), D, 0, 0, nullptr}; run_job(J, r % 1024, scr, lane); }
    }
    if (which == 0) {
        for (int m = gw; m < M; m += NGW) cvt_row(A.in(0) + (size_t)m * D, WSB(WS_XB) + (size_t)m * D, lane);
        for (int m = gw; m < 512; m += NGW) cvt_row(A.in(1) + (size_t)m * D, WSB(WS_MEMB) + (size_t)m * D, lane);
        float* tab = (float*)(ws + WS_TAB);
        for (int e = (F.vcu * NWAVES + F.wave) * 64 + lane; e < 3 * 16 * 129; e += NGW * 64) {
            const int g = e / (16 * 129), h = (e / 129) % 16, rel = e % 129;
            const int n = rel * (g == 0 ? 1 : (g == 1 ? 4 : 16));
            int bk = n;
            if (n >= 16) { const float v = logf((float)n / 16.0f) / 4.852030263919617f * 16.0f; bk = 16 + (int)v; if (bk > 31) bk = 31; }
            tab[e] = A.in(2)[bk * 16 + h] * LOG2E;
        }
    }
}

__device__ __forceinline__ void ln_phase(Frame& F, const float* g, const float* b, int write_xs) {
    const KArgs A = F.a; unsigned char* ws = A.ws(); const int lane = F.lane;
    const int gw = F.vcu * NWAVES + F.wave, NGW = F.G * NWAVES;
    f32x4 gv[4], bv[4];
#pragma unroll
    for (int j = 0; j < 4; ++j) { gv[j] = ((const f32x4*)g)[lane + 64 * j]; bv[j] = ((const f32x4*)b)[lane + 64 * j]; }
    bf16* XB = WSB(WS_XB); bf16* XS = WSB(WS_SCR + 4 * SLOT);
    for (int m = gw; m < M; m += NGW) {
        GAS f32x4* xr = (GAS f32x4*)(A.out() + (size_t)m * D) + lane;
        f32x4 v[4]; float s = 0.f;
#pragma unroll
        for (int j = 0; j < 4; ++j) { v[j] = xr[64 * j]; s += (v[j].x + v[j].y) + (v[j].z + v[j].w); }
        const float mean = wave_sum(s) * (1.f / D); float s2 = 0.f;
#pragma unroll
        for (int j = 0; j < 4; ++j) { v[j] = v[j] - mean; s2 += (v[j].x * v[j].x + v[j].y * v[j].y) + (v[j].z * v[j].z + v[j].w * v[j].w); }
        const float rstd = 1.f / sqrtf(wave_sum(s2) * (1.f / D) + LN_EPS);
        GAS unsigned long long* o8 = (GAS unsigned long long*)(XB + (size_t)m * D) + lane;
        GAS unsigned long long* s8 = (GAS unsigned long long*)(XS + (size_t)(m + 1) * D) + lane;
        const bool sh = write_xs && ((m + 1) % SEQ != 0);
#pragma unroll
        for (int j = 0; j < 4; ++j) {
            const f32x4 o = v[j] * rstd * gv[j] + bv[j];
            xr[64 * j] = o;
            const unsigned long long pk = (unsigned long long)pk2(o.x, o.y) | ((unsigned long long)pk2(o.z, o.w) << 32);
            o8[64 * j] = pk;
            if (sh) s8[64 * j] = pk;
        }
        if (write_xs && (m % SEQ == 0)) {
            GAS unsigned long long* z8 = (GAS unsigned long long*)(XS + (size_t)m * D) + lane;
#pragma unroll
            for (int j = 0; j < 4; ++j) z8[64 * j] = 0ull;
        }
    }
}

constexpr int CT = 16;
__device__ __forceinline__ void conv_phase(Frame& F, const bf16* U, bf16* C1, const float* dw, const float* dwb, const float* lg, const float* lb) {
    const int tid = F.tid, c0 = 2 * tid, lane = F.lane, wave = F.wave;
    LAS float* red = (LAS float*)(F.lds + RING_OFF);
    float dwr[31][2];
#pragma unroll
    for (int j = 0; j < 31; ++j) { const f32x2 t = *(const f32x2*)(dw + j * D + c0); dwr[j][0] = t.x; dwr[j][1] = t.y; }
    const f32x2 bb = *(const f32x2*)(dwb + c0), gg = *(const f32x2*)(lg + c0), lbb = *(const f32x2*)(lb + c0);
    for (int tile = F.vcu; tile < M / CT; tile += F.G) {
        const int b = tile / (SEQ / CT), t0 = (tile % (SEQ / CT)) * CT;
        float out[CT][2];
#pragma unroll
        for (int o = 0; o < CT; ++o) { out[o][0] = bb.x; out[o][1] = bb.y; }
#pragma unroll
        for (int i = 0; i < CT + 30; ++i) {
            const int t = t0 - 30 + i;
            unsigned w = 0u;
            if (t >= 0) w = *(const unsigned*)(U + (size_t)(b * SEQ + t) * D + c0);
            const float x0 = bflo(w), x1 = bfhi(w);
#pragma unroll
            for (int o = (i > 30 ? i - 30 : 0); o <= (i < CT ? i : CT - 1); ++o) { out[o][0] += x0 * dwr[i - o][0]; out[o][1] += x1 * dwr[i - o][1]; }
            if ((i & 7) == 7) asm volatile("" ::: "memory");
        }
        __syncthreads();
#pragma unroll
        for (int o = 0; o < CT; ++o) { const float s = wave_sum(out[o][0] + out[o][1]); if (lane == 0) red[o * 8 + wave] = s; }
        __syncthreads();
#pragma unroll
        for (int o = 0; o < CT; ++o) { const f32x4 a = *(const LAS f32x4*)(red + o * 8), c = *(const LAS f32x4*)(red + o * 8 + 4); const float mean = ((a.x + a.y) + (a.z + a.w) + (c.x + c.y) + (c.z + c.w)) * (1.f / D); out[o][0] -= mean; out[o][1] -= mean; }
        __syncthreads();
#pragma unroll
        for (int o = 0; o < CT; ++o) { const float s = wave_sum(out[o][0] * out[o][0] + out[o][1] * out[o][1]); if (lane == 0) red[o * 8 + wave] = s; }
        __syncthreads();
#pragma unroll
        for (int o = 0; o < CT; ++o) {
            const f32x4 a = *(const LAS f32x4*)(red + o * 8), c = *(const LAS f32x4*)(red + o * 8 + 4);
            const float rstd = 1.f / sqrtf(((a.x + a.y) + (a.z + a.w) + (c.x + c.y) + (c.z + c.w)) * (1.f / D) + LN_EPS);
            const float y0 = out[o][0] * rstd * gg.x + lbb.x, y1 = out[o][1] * rstd * gg.y + lbb.y;
            *(unsigned*)(C1 + (size_t)(b * SEQ + t0 + o) * D + c0) = pk2(y0 * sigm(y0), y1 * sigm(y1));
        }
    }
    __syncthreads();
}

__device__ __forceinline__ void combine_phase(Frame& F) {
    const KArgs A = F.a; unsigned char* ws = A.ws(); const int lane = F.lane;
    const int gw = F.vcu * NWAVES + F.wave, NGW = F.G * NWAVES;
    const float* lse = (const float*)(ws + WS_LSE);
    for (int m = gw; m < M; m += NGW) {
        const int h = lane >> 2;
        const float l0 = lse[(size_t)m * 16 + h], l1 = lse[(size_t)(M + m) * 16 + h], l2 = lse[(size_t)(2 * M + m) * 16 + h];
        const float mx = fmaxf(l0, fmaxf(l1, l2));
        float w0 = __expf(l0 - mx), w1 = __expf(l1 - mx), w2 = __expf(l2 - mx);
        const float inv = 1.f / (w0 + w1 + w2); w0 *= inv; w1 *= inv; w2 *= inv;
#pragma unroll
        for (int hf = 0; hf < 2; ++hf) {
            const size_t off = (size_t)m * D + 16 * lane + 8 * hf;
            const v4u a = *(const v4u*)(WSB(WS_SCR) + off), b = *(const v4u*)(WSB(WS_SCR + SLOT) + off), c = *(const v4u*)(WSB(WS_SCR + 2 * SLOT) + off);
            v4u o;
            o.x = pk2(w0 * bflo(a.x) + w1 * bflo(b.x) + w2 * bflo(c.x), w0 * bfhi(a.x) + w1 * bfhi(b.x) + w2 * bfhi(c.x));
            o.y = pk2(w0 * bflo(a.y) + w1 * bflo(b.y) + w2 * bflo(c.y), w0 * bfhi(a.y) + w1 * bfhi(b.y) + w2 * bfhi(c.y));
            o.z = pk2(w0 * bflo(a.z) + w1 * bflo(b.z) + w2 * bflo(c.z), w0 * bfhi(a.z) + w1 * bfhi(b.z) + w2 * bfhi(c.z));
            o.w = pk2(w0 * bflo(a.w) + w1 * bflo(b.w) + w2 * bflo(c.w), w0 * bfhi(a.w) + w1 * bfhi(b.w) + w2 * bfhi(c.w));
            *(v4u*)(WSB(WS_SCR + 3 * SLOT) + off) = o;
        }
    }
}

__device__ __forceinline__ int crow(int r, int hi) { return (r & 3) + 8 * (r >> 2) + 4 * hi; }
typedef short v4i16_t __attribute__((ext_vector_type(4)));
__device__ __forceinline__ void datt_phase(Frame& F, bf16* QO, const bf16* Kg, const bf16* Vg, float* lse, const float* tabg, int dil) {
    const int tid = F.tid, lane = F.lane, w = F.wave, r32 = lane & 31, hi = lane >> 5;
    LAS unsigned char* LK = F.lds + RING_OFF; LAS unsigned char* LV = LK + 49152; LAS unsigned char* LST = LK + 98304 + w * 4096;
    LAS float* TABX = (LAS float*)(F.lds + XTRA_OFF); LAS float* WSF = TABX + 256 + w * 64;
    const int nqb = (SEQ / dil) / 256;
    const int per_bh = dil * nqb;
    for (int uid = F.vcu; uid < BATCH * 16 * 32; uid += F.G) {
        const int b = uid / (16 * per_bh), h = (uid / per_bh) % 16, rq = uid % per_bh, res = rq / nqb, qblk = rq % nqb;
        const int q0 = qblk * 256;
        const size_t rowb = (size_t)b * SEQ + res;
        v4u kreg[6], vreg[6];
#pragma unroll
        for (int p = 0; p < 6; ++p) { const int idx = p * 64 + (tid >> 3); int j = q0 - 128 + idx; j = j < 0 ? 0 : j;
            const size_t off = (rowb + (size_t)dil * j) * D + h * 64 + (tid & 7) * 8;
            kreg[p] = *(const v4u*)(Kg + off); vreg[p] = *(const v4u*)(Vg + off); }
        const size_t qrow = rowb + (size_t)dil * (q0 + 32 * w + r32);
        bf16x8 qr[4];
#pragma unroll
        for (int d0 = 0; d0 < 4; ++d0) qr[d0] = *(const bf16x8*)(QO + qrow * D + h * 64 + 16 * d0 + 8 * hi);
        __syncthreads();
#pragma unroll
        for (int p = 0; p < 6; ++p) { const int idx = p * 64 + (tid >> 3), ch = tid & 7;
            *(LAS v4u*)(LK + idx * 128 + ((ch ^ ((idx >> 1) & 7)) << 4)) = kreg[p];
            *(LAS v4u*)(LV + idx * 128 + ((ch ^ (((idx >> 1) & 1) << 2)) << 4)) = vreg[p]; }
        if (tid < 192) { const int rel = tid - 31; TABX[tid] = (rel >= 0 && rel <= 128) ? tabg[h * 129 + rel] : -1.0e30f; }
        __syncthreads();
        f32x16 p[5];
#pragma unroll
        for (int blk = 0; blk < 5; ++blk) {
            p[blk] = (f32x16){0.f, 0.f, 0.f, 0.f, 0.f, 0.f, 0.f, 0.f, 0.f, 0.f, 0.f, 0.f, 0.f, 0.f, 0.f, 0.f};
            const int krow = 32 * (w + blk) + r32;
#pragma unroll
            for (int d0 = 0; d0 < 4; ++d0) {
                const bf16x8 kf = *(const LAS bf16x8*)(LK + krow * 128 + (((2 * d0 + hi) ^ ((r32 >> 1) & 7)) << 4));
                p[blk] = __builtin_amdgcn_mfma_f32_32x32x16_bf16(kf, qr[d0], p[blk], 0, 0, 0);
            }
        }
        float mx = -3.0e38f;
        const LAS float* tb = TABX + (r32 - 4 * hi);
#pragma unroll
        for (int blk = 0; blk < 5; ++blk) {
            const bool dead = (q0 == 0) && (w + blk < 4);
#pragma unroll
            for (int r = 0; r < 16; ++r) {
                float s = p[blk][r] + tb[159 - 32 * blk - (r & 3) - 8 * (r >> 2)];
                s = dead ? -1.0e30f : s;
                p[blk][r] = s; mx = fmaxf(mx, s);
            }
        }
        mx = fmaxf(mx, __shfl_xor(mx, 32));
        float l = 0.f;
#pragma unroll
        for (int blk = 0; blk < 5; ++blk)
#pragma unroll
            for (int r = 0; r < 16; ++r) { const float e = __builtin_amdgcn_exp2f(p[blk][r] - mx); p[blk][r] = e; l += e; }
        l += __shfl_xor(l, 32);
        if (hi == 0) { WSF[r32] = 1.0f / l; lse[qrow * 16 + h] = (mx + __builtin_amdgcn_logf(l)) * LN2; }
        f32x16 o[2];
        o[0] = (f32x16){0.f, 0.f, 0.f, 0.f, 0.f, 0.f, 0.f, 0.f, 0.f, 0.f, 0.f, 0.f, 0.f, 0.f, 0.f, 0.f}; o[1] = o[0];
        const int vrow0 = 4 * hi + ((lane & 15) >> 2), ch0 = 2 * ((lane >> 4) & 1) + ((lane & 3) >> 1), hf = lane & 1;
#pragma unroll
        for (int blk = 0; blk < 5; ++blk)
#pragma unroll
            for (int s = 0; s < 2; ++s) {
                v4u pw; pw.x = pk2(p[blk][8 * s], p[blk][8 * s + 1]); pw.y = pk2(p[blk][8 * s + 2], p[blk][8 * s + 3]); pw.z = pk2(p[blk][8 * s + 4], p[blk][8 * s + 5]); pw.w = pk2(p[blk][8 * s + 6], p[blk][8 * s + 7]);
                const bf16x8 pa = __builtin_bit_cast(bf16x8, pw);
#pragma unroll
                for (int d0 = 0; d0 < 2; ++d0) {
                    const int row0 = 32 * (w + blk) + 16 * s + vrow0;
                    const int cx = ((4 * d0 + ch0) ^ (((vrow0 >> 1) & 1) << 2)) << 4;
                    const v4i16_t lo = __builtin_amdgcn_ds_read_tr16_b64_v4i16((LAS v4i16_t*)(LV + row0 * 128 + cx + hf * 8));
                    const v4i16_t hh = __builtin_amdgcn_ds_read_tr16_b64_v4i16((LAS v4i16_t*)(LV + (row0 + 8) * 128 + cx + hf * 8));
                    const bf16x8 vf = (bf16x8){lo[0], lo[1], lo[2], lo[3], hh[0], hh[1], hh[2], hh[3]};
                    o[d0] = __builtin_amdgcn_mfma_f32_32x32x16_bf16(pa, vf, o[d0], 0, 0, 0);
                }
            }
        LDS_WAIT();
        LAS bf16* stg = (LAS bf16*)LST;
#pragma unroll
        for (int r = 0; r < 16; ++r) { const int q = crow(r, hi); const float il = WSF[q];
            stg[q * 64 + r32] = (bf16)f2bf(o[0][r] * il); stg[q * 64 + 32 + r32] = (bf16)f2bf(o[1][r] * il); }
        LDS_WAIT(); asm volatile("" ::: "memory");
#pragma unroll
        for (int i = 0; i < 4; ++i) { const int row = i * 8 + (lane >> 3), ch = lane & 7;
            const v4u v = *(const LAS v4u*)(stg + row * 64 + ch * 8);
            *(v4u*)(QO + (rowb + (size_t)dil * (q0 + 32 * w + row)) * D + h * 64 + ch * 8) = v; }
    }
    __syncthreads();
}

namespace sc {
constexpr int IM_KT = 0, IM_BT = 8192, IM_KK = 16384, IM_RT = 24576, IM_KTT = 32768, IM_BPT = 40960, IM_KPT = 49152, IM_VT = 57344,
              IM_A2 = 65536, IM_A3 = 73728, IM_A4 = 81920, IM_T = 90112, IM_P1T = 98304, IM_C0T = 106496, IM_C1T = 114688;
constexpr int TF_OFF = 0, A1F_OFF = 98304, FLD = 68;
constexpr int PS_OFF = XTRA_OFF, WF_OFF = XTRA_OFF + 2048, W2_OFF = XTRA_OFF + 4352;
typedef float f32x4_t __attribute__((ext_vector_type(4)));
__device__ __forceinline__ int img_off(int row, int col) { return row * 128 + ((((col >> 3) ^ (row >> 1)) & 7) << 4) + (col & 7) * 2; }
__device__ __forceinline__ bf16x8 frag(LAS unsigned char* img, int rb, int ks, int lane) { return *(const LAS bf16x8*)(img + img_off(16 * rb + (lane & 15), 32 * ks + 8 * (lane >> 4))); }
__device__ __forceinline__ void wr4(LAS unsigned char* img, int jb, int ib, int lane, f32x4 d) {
    v2u p; p.x = pk2(d[0], d[1]); p.y = pk2(d[2], d[3]);
    *(LAS v2u*)(img + img_off(16 * jb + (lane & 15), 16 * ib + 4 * (lane >> 4))) = p;
}
__device__ __forceinline__ f32x4 mm2(bf16x8 a0, bf16x8 a1, bf16x8 b0, bf16x8 b1, f32x4 c) {
    c = __builtin_amdgcn_mfma_f32_16x16x32_bf16(a0, b0, c, 0, 0, 0); return __builtin_amdgcn_mfma_f32_16x16x32_bf16(a1, b1, c, 0, 0, 0);
}
__device__ __forceinline__ unsigned long long pk4(f32x4 d) { return (unsigned long long)pk2(d[0], d[1]) | ((unsigned long long)pk2(d[2], d[3]) << 32); }
}

__device__ __forceinline__ void scan1_phase(Frame& F, bf16* Rb, bf16* Kb, const bf16* Vb, bf16* LWb, bf16* Ab, float* GL, float* BON,
                                            const float* k_k, const float* k_a, const float* r_k) {
    using namespace sc;
    const int tid = F.tid, lane = F.lane, w = F.wave;
    LAS unsigned char* L = F.lds;
    const f32x4 Z4 = (f32x4){0.f, 0.f, 0.f, 0.f};
    for (int item = F.vcu; item < 32 * 128; item += F.G) {
        const int bh = item >> 7, c = item & 127, b = bh >> 4, h = bh & 15, col = h * 64;
        const size_t rowbase = (size_t)b * SEQ + c * 64;
        const float kkc = k_k[col + lane], kac = k_a[col + lane], rkc = r_k[col + lane];
        float kv[8], rv[8], vv[8], av[8], cl[8], lwv[8];
#pragma unroll
        for (int tt = 0; tt < 8; ++tt) { const size_t idx = (rowbase + 8 * w + tt) * D + col + lane;
            kv[tt] = bf2f(Kb[idx]); rv[tt] = bf2f(Rb[idx]); vv[tt] = bf2f(Vb[idx]); av[tt] = bf2f(Ab[idx]); lwv[tt] = bf2f(LWb[idx]); }
        float run = 0.f;
#pragma unroll
        for (int tt = 0; tt < 8; ++tt) { run += lwv[tt]; cl[tt] = run; }
        __syncthreads();
        ((LAS float*)(L + PS_OFF))[w * 64 + lane] = run;
        __syncthreads();
        float offs = 0.f, total = 0.f;
#pragma unroll
        for (int ww = 0; ww < 8; ++ww) { const float p = ((LAS float*)(L + PS_OFF))[ww * 64 + lane]; if (ww < w) offs += p; total += p; }
        if (w == 0) GL[(size_t)(bh * 128 + c) * 64 + lane] = __expf(total);
        unsigned short ktT[8], bpT[8], kpT[8], vT[8];
#pragma unroll
        for (int tt = 0; tt < 8; ++tt) {
            const int t = 8 * w + tt; const float cc = cl[tt] + offs;
            const float kkr = kv[tt] * kkc; const float ss = wave_sum(kkr * kkr);
            const float kk = kkr / fmaxf(sqrtf(ss), 1e-12f);
            const float kp = kv[tt] * (1.f + (av[tt] - 1.f) * kac);
            const float bon = wave_sum(rv[tt] * kp * rkc);
            if (lane == 0) BON[(rowbase + t) * 16 + h] = bon;
            const float g = __expf(cc), gi = __expf(-cc), gp = __expf(cc - lwv[tt]), gl = __expf(total - cc);
            const float bb = kk * av[tt];
            const unsigned short kt = (unsigned short)f2bf(kk * gp);
            *(LAS unsigned short*)(L + IM_KT + img_off(t, lane)) = kt;
            *(LAS unsigned short*)(L + IM_BT + img_off(t, lane)) = (unsigned short)f2bf(bb * gi);
            *(LAS unsigned short*)(L + IM_KK + img_off(t, lane)) = (unsigned short)f2bf(kp * gi);
            *(LAS unsigned short*)(L + IM_RT + img_off(t, lane)) = (unsigned short)f2bf(rv[tt] * g);
            ktT[tt] = kt; bpT[tt] = (unsigned short)f2bf(bb * gl); kpT[tt] = (unsigned short)f2bf(kp * gl); vT[tt] = (unsigned short)f2bf(vv[tt]);
        }
        {
            const int o = lane * 128 + (((w ^ (lane >> 1)) & 7) << 4);
#define SC_PK8(x) (v4u){(unsigned)x[0] | ((unsigned)x[1] << 16), (unsigned)x[2] | ((unsigned)x[3] << 16), (unsigned)x[4] | ((unsigned)x[5] << 16), (unsigned)x[6] | ((unsigned)x[7] << 16)}
            *(LAS v4u*)(L + IM_KTT + o) = SC_PK8(ktT); *(LAS v4u*)(L + IM_BPT + o) = SC_PK8(bpT); *(LAS v4u*)(L + IM_KPT + o) = SC_PK8(kpT); *(LAS v4u*)(L + IM_VT + o) = SC_PK8(vT);
#undef SC_PK8
        }
        __syncthreads();
        {
            const int tb = w >> 1, t = 16 * tb + (lane & 15);
            const bf16x8 kt0 = frag(L + IM_KT, tb, 0, lane), kt1 = frag(L + IM_KT, tb, 1, lane), rt0 = frag(L + IM_RT, tb, 0, lane), rt1 = frag(L + IM_RT, tb, 1, lane);
#pragma unroll
            for (int si = 0; si < 2; ++si) {
                const int sb = 2 * (w & 1) + si, s0 = 16 * sb + 4 * (lane >> 4);
                const bf16x8 b0 = frag(L + IM_BT, sb, 0, lane), b1 = frag(L + IM_BT, sb, 1, lane), q0 = frag(L + IM_KK, sb, 0, lane), q1 = frag(L + IM_KK, sb, 1, lane);
                f32x4 a1 = mm2(b0, b1, kt0, kt1, Z4), a2 = mm2(q0, q1, kt0, kt1, Z4), a3 = mm2(b0, b1, rt0, rt1, Z4), a4 = mm2(q0, q1, rt0, rt1, Z4);
#pragma unroll
                for (int e = 0; e < 4; ++e) { const int s = s0 + e; if (!(s < t)) { a1[e] = 0.f; a2[e] = 0.f; } if (!(s <= t)) { a3[e] = 0.f; a4[e] = 0.f; } }
                *(LAS f32x4*)(L + A1F_OFF + (t * FLD + s0) * 4) = a1;
                wr4(L + IM_A2, tb, sb, lane, a2); wr4(L + IM_A3, tb, sb, lane, a3); wr4(L + IM_A4, tb, sb, lane, a4);
            }
        }
        __syncthreads();
        LAS float* NF = (LAS float*)(L + A1F_OFF); LAS float* TF = (LAS float*)(L + TF_OFF);
        for (int i = tid; i < 64 * FLD; i += 512) TF[i] = 0.f;
        __syncthreads();
        if (w == 0) {
            const int blk = lane >> 4, cc = lane & 15, o = 16 * blk;
            float x[16];
#pragma unroll
            for (int r = 0; r < 16; ++r) {
                float acc = (r == cc) ? 1.f : 0.f;
#pragma unroll
                for (int s4 = 0; s4 < (r + 3) / 4; ++s4) { const f32x4 nv = *(const LAS f32x4*)(NF + (o + r) * FLD + o + 4 * s4);
#pragma unroll
                    for (int e = 0; e < 4; ++e) if (4 * s4 + e < r) acc -= nv[e] * x[4 * s4 + e]; }
                x[r] = acc; TF[(o + r) * FLD + o + cc] = acc;
            }
        }
        __syncthreads();
        {
            const int B2 = tid >> 8, i = (tid >> 4) & 15, j = tid & 15, o = 32 * B2;
            LAS float* WF = (LAS float*)(L + WF_OFF) + B2 * 16 * 17;
            float acc = 0.f;
#pragma unroll
            for (int k = 0; k < 16; ++k) acc += NF[(o + 16 + i) * FLD + o + k] * TF[(o + k) * FLD + o + j];
            WF[i * 17 + j] = acc;
            __syncthreads();
            float acc2 = 0.f;
#pragma unroll
            for (int k = 0; k < 16; ++k) acc2 += TF[(o + 16 + i) * FLD + o + 16 + k] * WF[k * 17 + j];
            TF[(o + 16 + i) * FLD + o + j] = -acc2;
        }
        __syncthreads();
        {
            const int i = tid >> 4, j = tid & 15;
            LAS float* W2 = (LAS float*)(L + W2_OFF);
            float a0 = 0.f, a1 = 0.f;
#pragma unroll 8
            for (int k = 0; k < 32; ++k) { const float n = NF[(32 + i) * FLD + k]; a0 += n * TF[k * FLD + j]; a1 += n * TF[k * FLD + j + 16]; }
            W2[i * 36 + j] = a0; W2[i * 36 + j + 16] = a1;
            __syncthreads();
            float c0 = 0.f, c1 = 0.f;
#pragma unroll 8
            for (int k = 0; k < 32; ++k) { const float tv = TF[(32 + i) * FLD + 32 + k]; c0 += tv * W2[k * 36 + j]; c1 += tv * W2[k * 36 + j + 16]; }
            TF[(32 + i) * FLD + j] = -c0; TF[(32 + i) * FLD + j + 16] = -c1;
        }
        __syncthreads();
        {
            const int t = tid >> 3, ch = tid & 7; const LAS float* src = TF + t * FLD + 8 * ch;
            const f32x4 p0 = *(const LAS f32x4*)src, p1 = *(const LAS f32x4*)(src + 4);
            v4u o; o.x = pk2(p0[0], p0[1]); o.y = pk2(p0[2], p0[3]); o.z = pk2(p1[0], p1[1]); o.w = pk2(p1[2], p1[3]);
            *(LAS v4u*)(L + IM_T + t * 128 + (((ch ^ (t >> 1)) & 7) << 4)) = o;
        }
        __syncthreads();
        {
            const int jb = w >> 1;
            const bf16x8 kq0 = frag(L + IM_KTT, jb, 0, lane), kq1 = frag(L + IM_KTT, jb, 1, lane), vq0 = frag(L + IM_VT, jb, 0, lane), vq1 = frag(L + IM_VT, jb, 1, lane);
#pragma unroll
            for (int ti = 0; ti < 2; ++ti) { const int tb = 2 * (w & 1) + ti;
                const f32x4 p = mm2(frag(L + IM_T, tb, 0, lane), frag(L + IM_T, tb, 1, lane), kq0, kq1, Z4);
                const f32x4 q = mm2(frag(L + IM_A2, tb, 0, lane), frag(L + IM_A2, tb, 1, lane), vq0, vq1, Z4);
                wr4(L + IM_P1T, jb, tb, lane, -p); wr4(L + IM_C0T, jb, tb, lane, q); }
        }
        __syncthreads();
        {
            const int jb = w >> 1;
            const bf16x8 c0 = frag(L + IM_C0T, jb, 0, lane), c1 = frag(L + IM_C0T, jb, 1, lane);
#pragma unroll
            for (int ti = 0; ti < 2; ++ti) { const int tb = 2 * (w & 1) + ti;
                const f32x4 p = mm2(frag(L + IM_T, tb, 0, lane), frag(L + IM_T, tb, 1, lane), c0, c1, Z4);
                wr4(L + IM_C1T, jb, tb, lane, -p); }
        }
        __syncthreads();
        {
            const int jb = w >> 1, jj = 16 * jb + (lane & 15);
            const bf16x8 a3_0 = frag(L + IM_A3, jb, 0, lane), a3_1 = frag(L + IM_A3, jb, 1, lane), a4_0 = frag(L + IM_A4, jb, 0, lane), a4_1 = frag(L + IM_A4, jb, 1, lane);
            const bf16x8 bp0 = frag(L + IM_BPT, jb, 0, lane), bp1 = frag(L + IM_BPT, jb, 1, lane), kp0 = frag(L + IM_KPT, jb, 0, lane), kp1 = frag(L + IM_KPT, jb, 1, lane);
            const size_t grow = (rowbase + jj) * D + col;
#pragma unroll
            for (int ii = 0; ii < 2; ++ii) { const int ib = 2 * (w & 1) + ii, i0 = 16 * ib + 4 * (lane >> 4);
                const bf16x8 p0 = frag(L + IM_P1T, ib, 0, lane), p1 = frag(L + IM_P1T, ib, 1, lane), c0 = frag(L + IM_C1T, ib, 0, lane), c1 = frag(L + IM_C1T, ib, 1, lane),
                             v0 = frag(L + IM_VT, ib, 0, lane), v1 = frag(L + IM_VT, ib, 1, lane);
                f32x4 rq = mm2(p0, p1, a3_0, a3_1, Z4);
                { const v2u rr = *(const LAS v2u*)(L + IM_RT + img_off(jj, i0)); rq[0] += bflo(rr.x); rq[1] += bfhi(rr.x); rq[2] += bflo(rr.y); rq[3] += bfhi(rr.y); }
                f32x4 yl = mm2(v0, v1, a4_0, a4_1, Z4); yl = mm2(c0, c1, a3_0, a3_1, yl);
                const f32x4 mp = mm2(p0, p1, bp0, bp1, Z4);
                f32x4 nc = mm2(v0, v1, kp0, kp1, Z4); nc = mm2(c0, c1, bp0, bp1, nc);
                *(unsigned long long*)(LWb + grow + i0) = pk4(rq);
                *(unsigned long long*)(Ab + grow + i0) = pk4(yl);
                *(unsigned long long*)(Rb + grow + i0) = pk4(mp);
                *(unsigned long long*)(Kb + grow + i0) = pk4(nc);
            }
        }
    }
    __syncthreads();
}

__device__ __forceinline__ void scan2_phase(Frame& F, const bf16* Mb, const bf16* Nb, const float* GL, bf16* Sc) {
    using namespace sc;
    if (F.vcu >= 128) return;
    const int tid = F.tid, lane = F.lane, w = F.wave;
    const int bh = F.vcu >> 2, vb = F.vcu & 3, b = bh >> 4, h = bh & 15, col = h * 64;
    LAS unsigned char* SB = F.lds;
    const int kp = 16 * (w & 3) + (lane & 15);
    f32x4 S = (f32x4){0.f, 0.f, 0.f, 0.f};
    bf16x8 bm0, bm1; v2u ncw; float gl;
    auto loadc = [&](int c) {
        const size_t rb = ((size_t)b * SEQ + c * 64 + kp) * D + col;
        bm0 = *(const bf16x8*)(Mb + rb + 8 * (lane >> 4)); bm1 = *(const bf16x8*)(Mb + rb + 32 + 8 * (lane >> 4));
        ncw = *(const v2u*)(Nb + rb + 16 * vb + 4 * (lane >> 4));
        gl = GL[(size_t)(bh * 128 + c) * 64 + kp];
    };
    if (w < 4) loadc(0);
    for (int c = 0; c < 128; ++c) {
        if (w < 4) {
#pragma unroll
            for (int e = 0; e < 4; ++e) *(LAS unsigned short*)(SB + img_off(4 * (lane >> 4) + e, kp)) = (unsigned short)f2bf(S[e]);
        }
        __syncthreads();
        if (tid < 128) { const int row = tid >> 3, ch = tid & 7;
            const v4u sv = *(const LAS v4u*)(SB + row * 128 + (((ch ^ (row >> 1)) & 7) << 4));
            *(v4u*)(Sc + ((size_t)b * SEQ + c * 64 + 16 * vb + row) * D + col + 8 * ch) = sv; }
        if (w < 4) {
            const bf16x8 a0 = frag(SB, 0, 0, lane), a1 = frag(SB, 0, 1, lane);
            const bf16x8 m0 = bm0, m1 = bm1; const v2u nw = ncw; const float g = gl;
            if (c + 1 < 128) loadc(c + 1);
            const f32x4 d = mm2(a0, a1, m0, m1, (f32x4){0.f, 0.f, 0.f, 0.f});
            S[0] = S[0] * g + d[0] + bflo(nw.x); S[1] = S[1] * g + d[1] + bfhi(nw.x); S[2] = S[2] * g + d[2] + bflo(nw.y); S[3] = S[3] * g + d[3] + bfhi(nw.y);
        }
        __syncthreads();
    }
}

__device__ __forceinline__ void scan3_phase(Frame& F, bf16* Yb  , const bf16* Vb, const bf16* YLb, const bf16* RQb, const bf16* Sc, const float* BON,
                                            const float* lnx_g, const float* lnx_b) {
    using namespace sc;
    const int lane = F.lane, w = F.wave;
    for (int it2 = F.vcu; it2 < 32 * 128 / 2; it2 += F.G) {
        const int item = 2 * it2 + (w >> 2), bh = item >> 7, c = item & 127, b = bh >> 4, h = bh & 15, col = h * 64, tb = w & 3;
        const size_t rowbase = (size_t)b * SEQ + c * 64;
        const int t = 16 * tb + (lane & 15), q = lane >> 4;
        const size_t trow = (rowbase + t) * D + col;
        const bf16x8 rq0 = *(const bf16x8*)(RQb + trow + 8 * q), rq1 = *(const bf16x8*)(RQb + trow + 32 + 8 * q);
        f32x4 acc[4];
#pragma unroll
        for (int vb = 0; vb < 4; ++vb) {
            const size_t vrow = (rowbase + 16 * vb + (lane & 15)) * D + col;
            const bf16x8 s0 = *(const bf16x8*)(Sc + vrow + 8 * q), s1 = *(const bf16x8*)(Sc + vrow + 32 + 8 * q);
            const v2u yl = *(const v2u*)(YLb + trow + 16 * vb + 4 * q);
            acc[vb] = (f32x4){bflo(yl.x), bfhi(yl.x), bflo(yl.y), bfhi(yl.y)};
            acc[vb] = mm2(s0, s1, rq0, rq1, acc[vb]);
        }
        float s = 0.f;
#pragma unroll
        for (int vb = 0; vb < 4; ++vb) s += (acc[vb][0] + acc[vb][1]) + (acc[vb][2] + acc[vb][3]);
        s += __shfl_xor(s, 16); s += __shfl_xor(s, 32);
        const float mean = s * (1.f / 64.f); float s2 = 0.f;
#pragma unroll
        for (int vb = 0; vb < 4; ++vb)
#pragma unroll
            for (int e = 0; e < 4; ++e) { const float d = acc[vb][e] - mean; acc[vb][e] = d; s2 += d * d; }
        s2 += __shfl_xor(s2, 16); s2 += __shfl_xor(s2, 32);
        const float rstd = 1.f / sqrtf(s2 * (1.f / 64.f) + GN_EPS);
        const float bon = BON[(rowbase + t) * 16 + h];
#pragma unroll
        for (int vb = 0; vb < 4; ++vb) {
            const int v0 = 16 * vb + 4 * q;
            const f32x4 gg = *(const f32x4*)(lnx_g + col + v0), gb = *(const f32x4*)(lnx_b + col + v0);
            const v2u vw = *(const v2u*)(Vb + trow + v0);
            f32x4 o;
            o[0] = acc[vb][0] * rstd * gg[0] + gb[0] + bon * bflo(vw.x); o[1] = acc[vb][1] * rstd * gg[1] + gb[1] + bon * bfhi(vw.x);
            o[2] = acc[vb][2] * rstd * gg[2] + gb[2] + bon * bflo(vw.y); o[3] = acc[vb][3] * rstd * gg[3] + gb[3] + bon * bfhi(vw.y);
            *(unsigned long long*)(Yb + trow + v0) = sc::pk4(o);
        }
    }
}
enum { T_PROA = 0, T_PROB, T_GEMM_B, T_GEMM_RESID, T_GEMM_SOFTMAX, T_CONV, T_LN, T_DATT, T_COMBINE, T_SCAN1, T_SCAN2, T_SCAN3 };
constexpr int NPH = 60;
#ifdef ONLY
#define ON(k) ((k) == ONLY)
#else
#define ON(k) true
#endif
struct PD {
    int type;
    const char* A; const char* B; int lda, ldb, K, N, ksplit, smode; long kjump;
    int emode; bf16* O; bf16* O2; int ldc, split_cols; long split_stride; float scale0; const float* bias; const float* p0; const float* p1;
    const float* base;
    const float* g; const float* b; int flag; int layer;
};
__device__ __forceinline__ void pd_gemm(PD& d, int type, const void* A, int lda, const void* B, int ldb, int K, int N) {
    d.type = type; d.A = (const char*)A; d.lda = lda; d.B = (const char*)B; d.ldb = ldb; d.K = K; d.N = N; d.ksplit = 1 << 30; d.kjump = 0; d.smode = 0;
    d.emode = pg8::EM_PLAIN; d.O = nullptr; d.O2 = nullptr; d.ldc = 1024; d.split_cols = 0; d.split_stride = 0; d.scale0 = 1.f; d.bias = nullptr; d.p0 = nullptr; d.p1 = nullptr; d.base = nullptr;
}
__device__ __forceinline__ void pd_tail(PD& d, const KArgs a, int l, int t) {
    unsigned char* ws = a.ws(); const size_t xq = lw_xq(l);
    bf16* s0 = WSB(WS_SCR); bf16* s1 = WSB(WS_SCR + SLOT); bf16* s2 = WSB(WS_SCR + 2 * SLOT); bf16* XB = WSB(WS_XB);
    switch (t) {
    case 0: pd_gemm(d, T_GEMM_B, XB, D, WSB(xq), D, D, D); d.O = s0; d.split_cols = 1024; d.scale0 = 0.0625f * LOG2E; break;
    case 1: pd_gemm(d, T_GEMM_SOFTMAX, s0, D, WSB(WS_KB) + (size_t)l * 524288, D, 256, D); d.smode = 1; d.O = s1; break;
    case 2: pd_gemm(d, T_GEMM_B, s1, D, WSB(WS_VT) + (size_t)l * 524288, 512, 256, D); d.smode = 2; d.O = s2; break;
    case 3: pd_gemm(d, T_GEMM_RESID, s2, D, WSB(xq + 2 * MiB), D, D, D); d.base = a.out(); break;
    case 4: d.type = T_LN; d.g = a.in(34) + (size_t)(l * 3 + 1) * D; d.b = a.in(35) + (size_t)(l * 3 + 1) * D; d.flag = 0; break;
    case 5: pd_gemm(d, T_GEMM_B, XB, D, WSB(xq + 4 * MiB), D, D, FF); d.emode = pg8::EM_RELU2; d.O = s0; d.ldc = FF; break;
    case 6: pd_gemm(d, T_GEMM_RESID, s0, FF, WSB(xq + 12 * MiB), FF, FF, D); d.base = a.out(); break;
    default: d.type = T_LN; d.g = a.in(34) + (size_t)(l * 3 + 2) * D; d.b = a.in(35) + (size_t)(l * 3 + 2) * D; d.flag = (l == 1); break;
    }
}
__device__ __forceinline__ void make_pd(PD& d, const KArgs a, int ph) {
    unsigned char* ws = a.ws();
    bf16* s0 = WSB(WS_SCR); bf16* s1 = WSB(WS_SCR + SLOT); bf16* s2 = WSB(WS_SCR + 2 * SLOT); bf16* s3 = WSB(WS_SCR + 3 * SLOT); bf16* s4 = WSB(WS_SCR + 4 * SLOT); bf16* XB = WSB(WS_XB);
    d.type = -1; d.flag = 0; d.layer = 0; d.g = nullptr; d.b = nullptr;
    if (ph == 0) { d.type = T_PROA; return; }
    if (ph == 1) { pd_gemm(d, T_GEMM_B, nullptr, D, nullptr, D, D, D); d.smode = 3; d.emode = pg8::EM_KV; return; }
    if (ph == 14) { d.type = T_PROB; return; }
    int l, t;
    if (ph < 14) { l = 0; t = ph - 2; } else if (ph < 32) { l = 1; t = ph - 15; } else if (ph < 48) { l = 2; t = ph - 32; } else { l = 3; t = ph - 48; }
    d.layer = l;
    const int kind = l % 3, j = l / 3;
    const int nhead = kind == 0 ? 4 : (kind == 1 ? 9 : 8);
    if (t >= nhead) { pd_tail(d, a, l, t - nhead); return; }
    const float* lng = a.in(34) + (size_t)(l * 3) * D; const float* lnb = a.in(35) + (size_t)(l * 3) * D;
    if (kind == 0) {
        switch (t) {
        case 0: pd_gemm(d, T_GEMM_B, XB, D, WSB(WS_WA), D, D, 2 * D); d.emode = pg8::EM_GLU; d.O = s0; d.bias = a.in(4) + (size_t)j * 2 * D; break;
        case 1: d.type = T_CONV; break;
        case 2: pd_gemm(d, T_GEMM_RESID, s1, D, WSB(WS_WA + 4 * MiB), D, D, D); d.base = (l == 0) ? a.in(0) : a.out(); d.bias = a.in(10) + (size_t)j * D; break;
        default: d.type = T_LN; d.g = lng; d.b = lnb; break;
        }
    } else if (kind == 1) {
        if (t < 6) {
            const int g = t >> 1;
            if ((t & 1) == 0) { pd_gemm(d, T_GEMM_B, XB, D, WSB(WS_WB) + (size_t)g * 3072 * D, D, D, 3072); d.O = WSB(WS_SCR + g * SLOT); d.O2 = s3; d.split_cols = 1024; d.split_stride = SLOT / 2; d.scale0 = 0.125f * LOG2E; }
            else { d.type = T_DATT; d.flag = g; }
        } else if (t == 6) d.type = T_COMBINE;
        else if (t == 7) { pd_gemm(d, T_GEMM_RESID, s3, D, WSB(WS_WB + 18 * MiB), D, D, D); d.base = a.out(); }
        else { d.type = T_LN; d.g = lng; d.b = lnb; }
    } else {
        switch (t) {
        case 0: pd_gemm(d, T_GEMM_B, XB, D, WSB(WS_WC), 2 * D, 2 * D, 3328); d.ksplit = 16; d.kjump = (long)((const char*)s4 - (const char*)XB) - 16 * 128;
                d.emode = pg8::EM_RKV; d.O = s0; d.O2 = s1; d.split_cols = 1024; d.split_stride = SLOT / 2; break;
        case 1: pd_gemm(d, T_GEMM_B, WSB(WS_L), 256, WSB(WS_WC + 13 * MiB), 256, 256, 2 * D); d.emode = pg8::EM_L2A; d.O = s4; d.O2 = s3; d.split_cols = 1024; d.split_stride = 0; d.p0 = a.in(15); d.p1 = a.in(18); break;
        case 2: d.type = T_SCAN1; break;
        case 3: d.type = T_SCAN2; break;
        case 4: d.type = T_SCAN3; break;
        case 5: pd_gemm(d, T_GEMM_B, WSB(WS_L), 256, WSB(WS_WC + 13 * MiB) + (size_t)2048 * 256, 256, 256, D); d.emode = pg8::EM_L2B; d.O = s0; break;
        case 6: pd_gemm(d, T_GEMM_RESID, s0, D, WSB(WS_WC + 15 * MiB), D, D, D); d.base = a.out(); break;
        default: d.type = T_LN; d.g = lng; d.b = lnb; break;
        }
    }
}

__global__ void __launch_bounds__(NWAVES * 64, 2) fwd_kernel(Args) {
    extern __shared__ __attribute__((aligned(16))) unsigned char lds[];
    Frame F;
    F.lds = (LAS unsigned char*)lds; F.a.p = (const char CAS*)__builtin_amdgcn_kernarg_segment_ptr();
    const int wave_s = __builtin_amdgcn_readfirstlane((int)threadIdx.x >> 6);
    F.tid = threadIdx.x; F.lane = F.tid & 63; F.wave = wave_s;
    F.G = gridDim.x; { const int bx = blockIdx.x; F.vcu = (F.G % 8 == 0) ? (bx % 8) * (F.G / 8) + bx / 8 : bx; }
    unsigned char* ws = F.a.ws();
    const int ph_lo = F.a.ph_lo(), ph_hi = F.a.ph_hi();
    volatile LAS unsigned* MISC = (volatile LAS unsigned*)(F.lds + MISC_OFF);
    for (int u = F.tid; u < (XTRA_OFF - LDSCTL_OFF) / 4; u += NWAVES * 64) ((LAS unsigned*)(F.lds + LDSCTL_OFF))[u] = 0u;
    __syncthreads();
    const bool multi = (ph_hi - ph_lo) > 1;
    XcdBarrier bar; bar.bar = (unsigned*)(ws + WS_CTL) + CW_BAR; bar.x = 0; bar.st = nullptr;
    if (multi) bar = xcd_barrier_post((unsigned*)(ws + WS_CTL) + CW_BAR, MISC + 8, F.tid);

#pragma unroll 1
    for (int ph = ph_lo; ph < ph_hi; ++ph) {
        { int l_ = (int)__builtin_amdgcn_mbcnt_hi(~0u, __builtin_amdgcn_mbcnt_lo(~0u, 0u)); asm volatile("" : "+v"(l_)); F.lane = l_; F.wave = wave_s; F.tid = wave_s * 64 + l_; }
        { const char CAS* kp_ = (const char CAS*)__builtin_amdgcn_kernarg_segment_ptr(); asm volatile("" : "+s"(kp_)); F.a.p = kp_; }
        unsigned char* ws = F.a.ws();
        PD d; make_pd(d, F.a, ph);
        switch (d.type) {
        case T_PROA: if (ON(T_PROA)) pro_phase(F, 0); break;
        case T_PROB: if (ON(T_PROB)) pro_phase(F, 1); break;
        case T_GEMM_B: if (ON(T_GEMM_B)) {
            pg8::Gemm g{d.lda, d.ldb, d.K, d.ksplit, d.kjump};
            pg8::Sched S; S.nM = M / 256; S.nN = d.N / 256; S.nwg = S.nM * S.nN; S.G = F.G; S.c = (int)blockIdx.x; S.mode = d.smode; S.A = d.A; S.B = d.B; S.tA = (long)256 * d.lda * 2; S.tB = (long)256 * d.ldb * 2;
            S.memb = (const char*)(ws + WS_MEMB); S.wxkv = (const char*)(ws + WS_SCR + 4 * SLOT);
            pg8::EpiB E{d.emode, d.O, d.O2, d.ldc, d.split_cols, d.split_stride, d.scale0, d.bias, d.p0, d.p1, WSB(WS_KB), WSB(WS_VT), WSB(WS_L)};
            pg8::gemm_phase<pg8::EpiB, true>(F.lds + RING_OFF, g, S, E, F.tid);
        } break;
        case T_GEMM_RESID: if (ON(T_GEMM_RESID)) {
            pg8::Gemm g{d.lda, d.ldb, d.K, d.ksplit, d.kjump};
            pg8::Sched S; S.nM = M / 256; S.nN = d.N / 256; S.nwg = S.nM * S.nN; S.G = F.G; S.c = (int)blockIdx.x; S.mode = 0; S.A = d.A; S.B = d.B; S.tA = (long)256 * d.lda * 2; S.tB = (long)256 * d.ldb * 2; S.memb = nullptr; S.wxkv = nullptr;
            pg8::EpiResid E{d.base, F.a.out(), d.bias, ALPHA};
            pg8::gemm_phase<pg8::EpiResid, true>(F.lds + RING_OFF, g, S, E, F.tid);
        } break;
        case T_GEMM_SOFTMAX: if (ON(T_GEMM_SOFTMAX)) {
            pg8::Gemm g{d.lda, d.ldb, d.K, d.ksplit, d.kjump};
            pg8::Sched S; S.nM = M / 256; S.nN = d.N / 256; S.nwg = S.nM * S.nN; S.G = F.G; S.c = (int)blockIdx.x; S.mode = 1; S.A = d.A; S.B = d.B; S.tA = 0; S.tB = 0; S.memb = nullptr; S.wxkv = nullptr;
            pg8::EpiSoftmax E{d.O};
            pg8::gemm_phase<pg8::EpiSoftmax, false>(F.lds + RING_OFF, g, S, E, F.tid);
        } break;
        case T_CONV: if (ON(T_CONV)) { const int j = d.layer / 3;
            conv_phase(F, WSB(WS_SCR), WSB(WS_SCR + SLOT), F.a.in(5) + (size_t)j * 31 * D, F.a.in(6) + (size_t)j * D, F.a.in(7) + (size_t)j * D, F.a.in(8) + (size_t)j * D); } break;
        case T_LN: if (ON(T_LN)) ln_phase(F, d.g, d.b, d.flag); break;
        case T_DATT: if (ON(T_DATT)) { const int g = d.flag;
            datt_phase(F, WSB(WS_SCR + g * SLOT), WSB(WS_SCR + 3 * SLOT), WSB(WS_SCR + 4 * SLOT), (float*)(ws + WS_LSE) + (size_t)g * M * 16, (const float*)(ws + WS_TAB) + g * 16 * 129, g == 0 ? 1 : (g == 1 ? 4 : 16)); } break;
        case T_COMBINE: if (ON(T_COMBINE)) combine_phase(F); break;
        case T_SCAN1: if (ON(T_SCAN1)) scan1_phase(F, WSB(WS_SCR), WSB(WS_SCR + SLOT), WSB(WS_SCR + 2 * SLOT), WSB(WS_SCR + 4 * SLOT), WSB(WS_SCR + 3 * SLOT), (float*)(ws + WS_LSE), (float*)(ws + WS_LSE + MiB), F.a.in(23), F.a.in(24), F.a.in(25)); break;
        case T_SCAN2: if (ON(T_SCAN2)) scan2_phase(F, WSB(WS_SCR), WSB(WS_SCR + SLOT), (const float*)(ws + WS_LSE), WSB(WS_XB)); break;
        case T_SCAN3: if (ON(T_SCAN3)) scan3_phase(F, WSB(WS_SCR), WSB(WS_SCR + 2 * SLOT), WSB(WS_SCR + 3 * SLOT), WSB(WS_SCR + 4 * SLOT), WSB(WS_XB), (const float*)(ws + WS_LSE + MiB), F.a.in(26), F.a.in(27)); break;
        default: break;
        }
        if (ph + 1 < ph_hi) xcd_barrier(bar, F.tid);
    }
}

extern "C" void kernel_launch(void* const* d_in, const int* in_sizes, int n_in, void* d_out, int out_size, void* d_ws, size_t ws_size, hipStream_t stream) {
    if (n_in != 36 || out_size != M * D || ws_size < WS_END) { fprintf(stderr, "kernel_launch: unexpected problem (n_in %d out %d ws %zu)\n", n_in, out_size, ws_size); return; }
    (void)in_sizes;
    if (hipFuncSetAttribute((const void*)fwd_kernel, hipFuncAttributeMaxDynamicSharedMemorySize, LDS_BYTES) != hipSuccess) { fprintf(stderr, "kernel_launch: hipFuncSetAttribute failed\n"); return; }
    const int grid = 256;
    (void)hipMemsetAsync((char*)d_ws + WS_CTL, 0, CTL_ZERO_BYTES, stream);
    Args a{};
    for (int i = 0; i < 36; ++i) a.in[i] = (const float*)d_in[i];
    a.out = (float*)d_out; a.ws = (unsigned char*)d_ws;
#ifndef ONE_LAUNCH
    for (int ph = 0; ph < NPH; ++ph) { a.ph_lo = ph; a.ph_hi = ph + 1; hipLaunchKernelGGL(fwd_kernel, dim3(grid), dim3(NWAVES * 64), LDS_BYTES, stream, a); }
#else
    a.ph_lo = 0; a.ph_hi = NPH; hipLaunchKernelGGL(fwd_kernel, dim3(grid), dim3(NWAVES * 64), LDS_BYTES, stream, a);
#endif
}
```
